# Optimizing an MI355X kernel written in HIP

```python
import math
import jax, jax.numpy as jnp
from jax import lax
import numpy as np

D_MODEL = 1024
BATCH = 16
SEQ = 2048
DEPTH = 2

RET_HEADS = 4
RET_QK_W = D_MODEL // 2
RET_V_W = D_MODEL
RET_QK_DIM = RET_QK_W // RET_HEADS
RET_V_DIM = RET_V_W // RET_HEADS
RET_CHUNK = 128
ROPE_BASE = 10000.0
SB_HEADS = 8
SB_W = D_MODEL // 2
SB_HEAD_DIM = SB_W // SB_HEADS
SB_BLOCK = 128
SSM_W = D_MODEL // 2
SSM_GROUP = 16
SSM_GROUPS = SSM_W // SSM_GROUP
SSM_STATE = 64
DT_MIN = 1e-3
DT_MAX = 1e-1

EPS = 1e-6
IN_SIZES = (RET_QK_W, RET_QK_W, RET_V_W, RET_V_W,
            SB_W, SB_W, SB_W, SB_W,
            SSM_W, SSM_W,
            D_MODEL, D_MODEL, D_MODEL)
IN_W = sum(IN_SIZES)

kernel_name = "hybrid_retention_stickbreak_s5_gated"

F32 = jnp.float32


def rmsnorm(t, g):
    tf = t.astype(F32)
    return tf * lax.rsqrt(jnp.mean(tf * tf, axis=-1, keepdims=True) + EPS) * g.astype(F32)


def rope(t, cos, sin):
    half = t.shape[-1] // 2
    t1, t2 = t[..., :half], t[..., half:]
    return jnp.concatenate([t1 * cos - t2 * sin, t2 * cos + t1 * sin], axis=-1)


def retention(q, k, v, q_norm, k_norm, out_norm, cos, sin):
    B_, S_ = q.shape[:2]
    q = rope(rmsnorm(q, q_norm), cos, sin)
    k = rope(rmsnorm(k, k_norm), cos, sin) * (RET_QK_DIM ** -0.5)
    v = v.astype(F32)
    n = S_ // RET_CHUNK
    qc = q.reshape(B_, n, RET_CHUNK, RET_HEADS, RET_QK_DIM)
    kc = k.reshape(B_, n, RET_CHUNK, RET_HEADS, RET_QK_DIM)
    vc = v.reshape(B_, n, RET_CHUNK, RET_HEADS, RET_V_DIM)
    log_gamma = jnp.log1p(-jnp.exp2(-5.0 - jnp.arange(RET_HEADS, dtype=F32)))
    idx = jnp.arange(RET_CHUNK, dtype=F32)
    rel = idx[:, None] - idx[None, :]
    decay = jnp.where(rel >= 0, jnp.exp(jnp.maximum(rel, 0.0)[None] * log_gamma[:, None, None]), 0.0)
    scores = jnp.einsum('bnihd,bnjhd->bnhij', qc, kc) * decay[None, None]
    inner = jnp.einsum('bnhij,bnjhe->bnihe', scores, vc)
    k_decay = jnp.exp((RET_CHUNK - 1 - idx)[:, None] * log_gamma[None])
    q_decay = jnp.exp((idx + 1)[:, None] * log_gamma[None])
    chunk_kv = jnp.einsum('bnjhd,bnjhe->nbhde', kc * k_decay[:, :, None], vc)
    chunk_decay = jnp.exp(RET_CHUNK * log_gamma)[None, :, None, None]

    def step(state, kv):
        return state * chunk_decay + kv, state

    _, prev = lax.scan(step, jnp.zeros_like(chunk_kv[0]), chunk_kv)
    cross = jnp.einsum('bnihd,nbhde->bnihe', qc * q_decay[:, :, None], prev)
    out = (inner + cross).reshape(B_, S_, RET_HEADS, RET_V_DIM)
    out = rmsnorm(out, out_norm.reshape(RET_HEADS, RET_V_DIM))
    return out.reshape(B_, S_, RET_V_W)


def stick_breaking(q, k, v, q_norm, k_norm):
    B_, S_ = q.shape[:2]
    q = rmsnorm(q, q_norm)
    k = rmsnorm(k, k_norm)
    v = v.astype(F32)
    scale = SB_HEAD_DIM ** -0.5
    outs = []
    for blk in range(S_ // SB_BLOCK):
        start = blk * SB_BLOCK
        end = start + SB_BLOCK
        z = jnp.einsum('bqhd,bkhd->bhqk', q[:, start:end], k[:, :end]) * scale
        t_idx = start + jnp.arange(SB_BLOCK)
        s_idx = jnp.arange(end)
        causal = s_idx[None, :] < t_idx[:, None]
        log_keep = jnp.where(causal, jax.nn.log_sigmoid(-z), 0.0)
        after = lax.cumsum(log_keep, axis=3, reverse=True) - log_keep
        w = jnp.where(causal, jnp.exp(jax.nn.log_sigmoid(z) + after), 0.0)
        outs.append(jnp.einsum('bhqk,bkhd->bqhd', w, v[:, :end]))
    return jnp.concatenate(outs, axis=1).reshape(B_, S_, SB_W)


def _ssm_combine(left, right):
    a1r, a1i, b1r, b1i = left
    a2r, a2i, b2r, b2i = right
    return (a2r * a1r - a2i * a1i,
            a2r * a1i + a2i * a1r,
            a2r * b1r - a2i * b1i + b2r,
            a2r * b1i + a2i * b1r + b2i)


def s5_ssm(u, a_re, a_im, log_dt, b_re, b_im, c_re, c_im, d_skip, w_glu, b_glu):
    B_, S_ = u.shape[:2]
    u = u.astype(F32)
    ug = jnp.swapaxes(u.reshape(B_, S_, SSM_GROUPS, SSM_GROUP), 0, 1)
    a_re = a_re.astype(F32)
    a_im = a_im.astype(F32)
    dt = jnp.exp(log_dt.astype(F32))[:, None]
    mag = jnp.exp(dt * a_re)
    ab_re = mag * jnp.cos(dt * a_im)
    ab_im = mag * jnp.sin(dt * a_im)
    den = a_re * a_re + a_im * a_im
    nr = ab_re - 1.0
    coef_re = (nr * a_re + ab_im * a_im) / den
    coef_im = (ab_im * a_re - nr * a_im) / den
    b_re = b_re.astype(F32)
    b_im = b_im.astype(F32)
    bb_re = coef_re[..., None] * b_re - coef_im[..., None] * b_im
    bb_im = coef_re[..., None] * b_im + coef_im[..., None] * b_re
    bu_re = jnp.einsum('sbgm,gpm->sbgp', ug, bb_re)
    bu_im = jnp.einsum('sbgm,gpm->sbgp', ug, bb_im)
    a_seq_re = jnp.broadcast_to(ab_re[None, None], (S_, 1, SSM_GROUPS, SSM_STATE))
    a_seq_im = jnp.broadcast_to(ab_im[None, None], (S_, 1, SSM_GROUPS, SSM_STATE))
    _, _, h_re, h_im = lax.associative_scan(_ssm_combine, (a_seq_re, a_seq_im, bu_re, bu_im), axis=0)
    y = (jnp.einsum('sbgp,gmp->sbgm', h_re, c_re.astype(F32))
         - jnp.einsum('sbgp,gmp->sbgm', h_im, c_im.astype(F32)))
    y = jnp.swapaxes(y, 0, 1).reshape(B_, S_, SSM_W) + d_skip.astype(F32) * u
    y = jax.nn.gelu(y)
    return y * jax.nn.sigmoid(y @ w_glu.astype(F32) + b_glu.astype(F32))


def hybrid_layer(x, norm_g, w_in, ret_q_norm, ret_k_norm, ret_out_norm, sb_q_norm, sb_k_norm,
                 ssm_a_re, ssm_a_im, ssm_log_dt, ssm_b_re, ssm_b_im, ssm_c_re, ssm_c_im,
                 ssm_d, ssm_w_glu, ssm_b_glu, proj_a, proj_b, proj_c, w_out, cos, sin):
    B_, S_, _ = x.shape
    h = rmsnorm(x, norm_g).astype(x.dtype)
    proj = h @ w_in
    points = []
    acc = 0
    for sz in IN_SIZES[:-1]:
        acc += sz
        points.append(acc)
    (rq, rk, rv, rz, sq, sk, sv, sz_, cu, cz, ga, gb, gc) = jnp.split(proj, points, axis=-1)
    y_a = retention(rq.reshape(B_, S_, RET_HEADS, RET_QK_DIM),
                    rk.reshape(B_, S_, RET_HEADS, RET_QK_DIM),
                    rv.reshape(B_, S_, RET_HEADS, RET_V_DIM),
                    ret_q_norm, ret_k_norm, ret_out_norm, cos, sin) * jax.nn.silu(rz.astype(F32))
    y_b = stick_breaking(sq.reshape(B_, S_, SB_HEADS, SB_HEAD_DIM),
                         sk.reshape(B_, S_, SB_HEADS, SB_HEAD_DIM),
                         sv.reshape(B_, S_, SB_HEADS, SB_HEAD_DIM),
                         sb_q_norm, sb_k_norm) * jax.nn.silu(sz_.astype(F32))
    y_c = s5_ssm(cu, ssm_a_re, ssm_a_im, ssm_log_dt, ssm_b_re, ssm_b_im, ssm_c_re, ssm_c_im,
                 ssm_d, ssm_w_glu, ssm_b_glu) * jax.nn.silu(cz.astype(F32))
    merged = (jax.nn.sigmoid(ga.astype(F32)) * (y_a @ proj_a.astype(F32))
              + jax.nn.sigmoid(gb.astype(F32)) * (y_b @ proj_b.astype(F32))
              + jax.nn.sigmoid(gc.astype(F32)) * (y_c @ proj_c.astype(F32)))
    return x + (merged @ w_out.astype(F32)).astype(x.dtype)


def setup_inputs(seed: int = 0) -> dict:
    key = jax.random.key(seed)
    ks = jax.random.split(key, 24)
    L = DEPTH

    def nrm(k, shape, std):
        return jax.random.normal(k, shape, F32) * std

    def gain(k, shape):
        return 1.0 + 0.05 * jax.random.normal(k, shape, F32)

    n_idx = jnp.arange(SSM_STATE, dtype=F32)
    a_re = -0.5 + 0.01 * jax.random.normal(ks[8], (L, SSM_GROUPS, SSM_STATE), F32)
    a_im = math.pi * n_idx + 0.01 * jax.random.normal(ks[9], (L, SSM_GROUPS, SSM_STATE), F32)
    log_dt = jax.random.uniform(ks[10], (L, SSM_GROUPS), F32, math.log(DT_MIN), math.log(DT_MAX))
    return {
        "x": jax.random.normal(ks[0], (BATCH, SEQ, D_MODEL), F32),
        "norm_g": gain(ks[1], (L, D_MODEL)),
        "w_in": nrm(ks[2], (L, D_MODEL, IN_W), D_MODEL ** -0.5),
        "ret_q_norm": gain(ks[3], (L, RET_QK_DIM)),
        "ret_k_norm": gain(ks[4], (L, RET_QK_DIM)),
        "ret_out_norm": gain(ks[5], (L, RET_V_W)),
        "sb_q_norm": gain(ks[6], (L, SB_HEAD_DIM)),
        "sb_k_norm": gain(ks[7], (L, SB_HEAD_DIM)),
        "ssm_a_re": a_re,
        "ssm_a_im": a_im,
        "ssm_log_dt": log_dt,
        "ssm_b_re": nrm(ks[11], (L, SSM_GROUPS, SSM_STATE, SSM_GROUP), (2 * SSM_GROUP) ** -0.5),
        "ssm_b_im": nrm(ks[12], (L, SSM_GROUPS, SSM_STATE, SSM_GROUP), (2 * SSM_GROUP) ** -0.5),
        "ssm_c_re": nrm(ks[13], (L, SSM_GROUPS, SSM_GROUP, SSM_STATE), SSM_STATE ** -0.5),
        "ssm_c_im": nrm(ks[14], (L, SSM_GROUPS, SSM_GROUP, SSM_STATE), SSM_STATE ** -0.5),
        "ssm_d": nrm(ks[15], (L, SSM_W), 1.0),
        "ssm_w_glu": nrm(ks[16], (L, SSM_W, SSM_W), SSM_W ** -0.5),
        "ssm_b_glu": nrm(ks[17], (L, SSM_W), 0.01),
        "proj_a": nrm(ks[18], (L, RET_V_W, D_MODEL), RET_V_W ** -0.5),
        "proj_b": nrm(ks[19], (L, SB_W, D_MODEL), SB_W ** -0.5),
        "proj_c": nrm(ks[20], (L, SSM_W, D_MODEL), SSM_W ** -0.5),
        "w_out": nrm(ks[21], (L, D_MODEL, D_MODEL), D_MODEL ** -0.5),
    }


def reference(x, norm_g, w_in, ret_q_norm, ret_k_norm, ret_out_norm, sb_q_norm, sb_k_norm,
              ssm_a_re, ssm_a_im, ssm_log_dt, ssm_b_re, ssm_b_im, ssm_c_re, ssm_c_im,
              ssm_d, ssm_w_glu, ssm_b_glu, proj_a, proj_b, proj_c, w_out):
    S_ = x.shape[1]
    half = RET_QK_DIM // 2
    inv_freq = ROPE_BASE ** (-jnp.arange(half, dtype=F32) / half)
    ang = jnp.arange(S_, dtype=F32)[:, None] * inv_freq[None, :]
    cos = jnp.cos(ang)[:, None, :]
    sin = jnp.sin(ang)[:, None, :]
    for l in range(DEPTH):
        x = hybrid_layer(x, norm_g[l], w_in[l], ret_q_norm[l], ret_k_norm[l], ret_out_norm[l],
                         sb_q_norm[l], sb_k_norm[l], ssm_a_re[l], ssm_a_im[l], ssm_log_dt[l],
                         ssm_b_re[l], ssm_b_im[l], ssm_c_re[l], ssm_c_im[l], ssm_d[l],
                         ssm_w_glu[l], ssm_b_glu[l], proj_a[l], proj_b[l], proj_c[l], w_out[l],
                         cos, sin)
    return x
```

```cpp
#include <hip/hip_runtime.h>
#include <hip/hip_cooperative_groups.h>
#include <cstdio>
#include <cstdint>
namespace cg = cooperative_groups;

typedef unsigned short bf16_t;
typedef short bf16x8 __attribute__((ext_vector_type(8)));
typedef short s16x4 __attribute__((ext_vector_type(4)));
typedef float f32x4 __attribute__((ext_vector_type(4)));
typedef float f32x16 __attribute__((ext_vector_type(16)));
typedef unsigned u32x4 __attribute__((ext_vector_type(4)));
#define DI __device__ __forceinline__
#define MFMA16(a, b, c) __builtin_amdgcn_mfma_f32_16x16x32_bf16((a), (b), (c), 0, 0, 0)
#define MFMA32(a, b, c) __builtin_amdgcn_mfma_f32_32x32x16_bf16((a), (b), (c), 0, 0, 0)

constexpr int DM = 1024, SEQ = 2048, HB = 8, TH = HB * SEQ  , PS = 7680  ;
constexpr float EPS = 1e-6f;
constexpr int C_RQ = 0, C_RK = 512, C_RZ = 1024, C_SQ = 2048, C_SK = 2560, C_SZ = 3072, C_CU = 3584, C_CZ = 4096, C_GA = 4608, C_GB = 5632, C_GC = 6656;
constexpr size_t W_IN_T = 0, W_GLU_T = 9437184, PA_T = 9699328, PB_T = 10747904, PC_T = 11272192, WO_T = 11796480, LAYER_W = 12845056;
constexpr size_t OFF_WT = 0;
constexpr size_t OFF_ROPE = 2 * LAYER_W * 2;
constexpr size_t OFF_H = OFF_ROPE + 2 * 2048 * 64 * 4;
constexpr size_t OFF_PROJ = OFF_H + (size_t)TH * 1024 * 2;
constexpr size_t OFF_RVT = OFF_PROJ + (size_t)TH * PS * 2;
constexpr size_t OFF_SVT = OFF_RVT + (size_t)8 * 4 * 256 * 2048 * 2;
constexpr size_t OFF_YA = OFF_SVT + (size_t)8 * 8 * 64 * 2048 * 2;
constexpr size_t OFF_YB = OFF_YA + (size_t)TH * 1024 * 2;
constexpr size_t OFF_YCP = OFF_YB + (size_t)TH * 512 * 2;
constexpr size_t OFF_YC = OFF_YCP + (size_t)TH * 512 * 2;
constexpr size_t OFF_KDT = OFF_YC + (size_t)TH * 512 * 2;
constexpr size_t OFF_SSQ = OFF_KDT + (size_t)8 * 4 * 128 * 2048 * 2;
constexpr size_t SSMT_KT = 0, SSMT_P = 16896, SSMT_Q = 16896 + 131072, SSMT_A32 = 16896 + 2 * 131072, SSMT_STRIDE = 16896 + 2 * 131072 + 512;
constexpr size_t OFF_SSMT = OFF_SSQ + (size_t)TH * 16 * 4;
constexpr size_t OFF_CTR = OFF_SSMT + 64 * SSMT_STRIDE;
constexpr size_t OFF_BAR = OFF_CTR + 256;
constexpr size_t WS_END = OFF_BAR + 3456 * 4;
static_assert(WS_END <= 536870912, "workspace map exceeds 4x the largest tensor");

constexpr int SMEM_BYTES = 67584;

struct Params { const float* in[22]; float* out; unsigned char* ws; int use_cg_sync; int pad_; };

DI unsigned char* ws_op(const Params& p) { size_t z = 0; asm volatile("" : "+s"(z)); return p.ws + z; }
DI float shx(float v, int k, int lane) { return __builtin_bit_cast(float, __builtin_amdgcn_ds_bpermute((lane ^ k) << 2, __builtin_bit_cast(int, v))); }
DI float bf2f(bf16_t v) { return __uint_as_float(((unsigned)v) << 16); }
DI bf16_t f2bf(float x) { unsigned u = __float_as_uint(x); u += 0x7fffu + ((u >> 16) & 1u); return (bf16_t)(u >> 16); }
DI unsigned pack2(float lo, float hi) { unsigned r; asm volatile("v_cvt_pk_bf16_f32 %0, %1, %2" : "=v"(r) : "v"(lo), "v"(hi)); return r; }
DI float sigmoidf_(float x) { return __builtin_amdgcn_rcpf(1.0f + __expf(-x)); }
DI float siluf_(float x) { return x * sigmoidf_(x); }
DI float gelu_tanh(float y) { float a = 0.7978845608028654f * (y + 0.044715f * y * y * y); float t = 1.0f - 2.0f * __builtin_amdgcn_rcpf(__expf(2.0f * a) + 1.0f); return 0.5f * y * (1.0f + t); }
DI void swap16(unsigned& a, unsigned& b) { asm volatile("v_nop\n\tv_nop\n\tv_permlane16_swap_b32 %0, %1" : "+v"(a), "+v"(b)); }
DI void store16_pair(bf16_t* rowp, uint2 a, uint2 b, int kq, int odd_off = 16) {
  swap16(a.x, b.x); swap16(a.y, b.y);
  *(u32x4*)(rowp + (kq & 1) * odd_off + (kq >> 1) * 8) = u32x4{a.x, a.y, b.x, b.y};
}
DI void load16_pair(const bf16_t* rowp, uint2& a, uint2& b, int kq, int odd_off = 16) {
  const u32x4 v = *(const u32x4*)(rowp + (kq & 1) * odd_off + (kq >> 1) * 8);
  a.x = v[0]; a.y = v[1]; b.x = v[2]; b.y = v[3];
  swap16(a.x, b.x); swap16(a.y, b.y);
}
DI void swap32(unsigned& a, unsigned& b) { asm volatile("v_nop\n\tv_nop\n\tv_permlane32_swap_b32 %0, %1" : "+v"(a), "+v"(b)); }
DI void store32_pair(bf16_t* p8  , uint2 a, uint2 b, int h2) {
  swap32(a.x, b.x); swap32(a.y, b.y);
  *(u32x4*)(p8 + h2 * 8) = u32x4{a.x, a.y, b.x, b.y};
}
DI void load32_pair(const bf16_t* p8, uint2& a, uint2& b, int h2) {
  const u32x4 v = *(const u32x4*)(p8 + h2 * 8);
  a.x = v[0]; a.y = v[1]; b.x = v[2]; b.y = v[3];
  swap32(a.x, b.x); swap32(a.y, b.y);
}
DI int crow(int reg, int h2) { return (reg & 3) + 8 * (reg >> 2) + 4 * h2; }
DI int tid_op() { int t = threadIdx.x; asm volatile("" : "+v"(t)); return t; }
struct Params;
DI unsigned char* ws_op(const Params& p);

constexpr int BK = 64;
DI int lds_byte2(int r, int c) { const int st = (r >> 4) * 2 + (c >> 5), ob = (r & 15) * 64 + (c & 31) * 2; return st * 1024 + (ob ^ (((ob >> 9) & 1) << 5)); }
DI void stage_rc2(int b, int& R, int& C) { const int st = b >> 10, sb = b & 1023, swz = sb ^ (((sb >> 9) & 1) << 5); R = (st >> 1) * 16 + (swz >> 6); C = (st & 1) * 32 + ((swz & 63) >> 1); }
#define WAIT_VM0() asm volatile("s_waitcnt vmcnt(0)" ::: "memory")
template <bool SWAP, int NJ>
DI void gemm_core(const bf16_t* __restrict__ A, int lda, const bf16_t* __restrict__ Bt, int ldb, int K, f32x4 (&acc)[4][NJ], unsigned char* sm, bool pre = false) {
  const int tid = tid_op(), lane = tid & 63, wid = tid >> 6, wm = wid >> 1, wn = wid & 1, fr = lane & 15, fq = lane >> 4;
  int aoff[4], boff[NJ];
#pragma unroll
  for (int i = 0; i < 4; ++i) { int R, C; stage_rc2(wid * 1024 + i * 4096 + lane * 16, R, C); aoff[i] = R * lda + C; }
#pragma unroll
  for (int i = 0; i < NJ; ++i) { int R, C; stage_rc2(wid * 1024 + i * 4096 + lane * 16, R, C); boff[i] = R * ldb + C; }
  const int lo = (fr * 64 + fq * 16) ^ ((fr >> 3) << 5);
  const int nt = K / BK;
  if (!pre) {
    __syncthreads();
#pragma unroll
    for (int i = 0; i < 4; ++i) __builtin_amdgcn_global_load_lds((const unsigned*)(A + aoff[i]), (__attribute__((address_space(3))) unsigned*)(sm + wid * 1024 + i * 4096), 16, 0, 0);
#pragma unroll
    for (int i = 0; i < NJ; ++i) __builtin_amdgcn_global_load_lds((const unsigned*)(Bt + boff[i]), (__attribute__((address_space(3))) unsigned*)(sm + 16384 + wid * 1024 + i * 4096), 16, 0, 0);
  }
  WAIT_VM0();
  __syncthreads();
  for (int t = 0; t < nt; ++t) {
    unsigned char* cur = sm + (t & 1) * 32768;
    unsigned char* nxt = sm + ((t & 1) ^ 1) * 32768;
    if (t + 1 < nt) {
      const int ko = (t + 1) * BK;
#pragma unroll
      for (int i = 0; i < 4; ++i) __builtin_amdgcn_global_load_lds((const unsigned*)(A + aoff[i] + ko), (__attribute__((address_space(3))) unsigned*)(nxt + wid * 1024 + i * 4096), 16, 0, 0);
#pragma unroll
      for (int i = 0; i < NJ; ++i) __builtin_amdgcn_global_load_lds((const unsigned*)(Bt + boff[i] + ko), (__attribute__((address_space(3))) unsigned*)(nxt + 16384 + wid * 1024 + i * 4096), 16, 0, 0);
    }
    bf16x8 af[2][4], bfr[2][NJ];
#pragma unroll
    for (int ks = 0; ks < 2; ++ks) {
#pragma unroll
      for (int i = 0; i < 4; ++i) af[ks][i] = *(const bf16x8*)(cur + ((wm * 4 + i) * 2 + ks) * 1024 + lo);
#pragma unroll
      for (int j = 0; j < NJ; ++j) bfr[ks][j] = *(const bf16x8*)(cur + 16384 + ((wn * NJ + j) * 2 + ks) * 1024 + lo);
      __builtin_amdgcn_sched_barrier(0);
    }
#pragma unroll
    for (int ks = 0; ks < 2; ++ks) {
#pragma unroll
      for (int i = 0; i < 4; ++i)
#pragma unroll
        for (int j = 0; j < NJ; ++j) acc[i][j] = SWAP ? MFMA16(bfr[ks][j], af[ks][i], acc[i][j]) : MFMA16(af[ks][i], bfr[ks][j], acc[i][j]);
      __builtin_amdgcn_sched_barrier(0);
    }
    WAIT_VM0();
    __syncthreads();
  }
}

DI void gemm_issue0(const bf16_t* __restrict__ A, int lda, const bf16_t* __restrict__ Bt, int ldb, unsigned char* sm) {
  const int tid = tid_op(), lane = tid & 63, wid = tid >> 6;
#pragma unroll
  for (int i = 0; i < 4; ++i) {
    int R, C; stage_rc2(wid * 1024 + i * 4096 + lane * 16, R, C);
    __builtin_amdgcn_global_load_lds((const unsigned*)(A + R * lda + C), (__attribute__((address_space(3))) unsigned*)(sm + wid * 1024 + i * 4096), 16, 0, 0);
    __builtin_amdgcn_global_load_lds((const unsigned*)(Bt + R * ldb + C), (__attribute__((address_space(3))) unsigned*)(sm + 16384 + wid * 1024 + i * 4096), 16, 0, 0);
  }
}
template <bool SWAP>
DI void gemm_core256(const bf16_t* __restrict__ A, int lda, const bf16_t* __restrict__ Bt, int ldb, int K, f32x4 (&acc)[8][4], unsigned char* sm) {
  const int tid = tid_op(), lane = tid & 63, wid = tid >> 6, wm = wid >> 1, wn = wid & 1, fr = lane & 15, fq = lane >> 4;
  int aoff[4], boff[2];
#pragma unroll
  for (int i = 0; i < 4; ++i) { const int b = wid * 1024 + i * 4096 + lane * 16, R = b >> 6, c = ((b >> 4) & 3) ^ ((-(R >> 2)) & 3); aoff[i] = R * lda + c * 8; }
#pragma unroll
  for (int i = 0; i < 2; ++i) { const int b = wid * 1024 + i * 4096 + lane * 16, R = b >> 6, c = ((b >> 4) & 3) ^ ((-(R >> 2)) & 3); boff[i] = R * ldb + c * 8; }
  const int lo = fr * 64 + ((fq ^ ((-(fr >> 2)) & 3)) << 4);
  const int nt = K / 32;
  __syncthreads();
#pragma unroll
  for (int i = 0; i < 4; ++i) __builtin_amdgcn_global_load_lds((const unsigned*)(A + aoff[i]), (__attribute__((address_space(3))) unsigned*)(sm + wid * 1024 + i * 4096), 16, 0, 0);
#pragma unroll
  for (int i = 0; i < 2; ++i) __builtin_amdgcn_global_load_lds((const unsigned*)(Bt + boff[i]), (__attribute__((address_space(3))) unsigned*)(sm + 16384 + wid * 1024 + i * 4096), 16, 0, 0);
  WAIT_VM0();
  __syncthreads();
  for (int t = 0; t < nt; ++t) {
    unsigned char* cur = sm + (t & 1) * 24576;
    unsigned char* nxt = sm + ((t & 1) ^ 1) * 24576;
    if (t + 1 < nt) {
      const int ko = (t + 1) * 32;
#pragma unroll
      for (int i = 0; i < 4; ++i) __builtin_amdgcn_global_load_lds((const unsigned*)(A + aoff[i] + ko), (__attribute__((address_space(3))) unsigned*)(nxt + wid * 1024 + i * 4096), 16, 0, 0);
#pragma unroll
      for (int i = 0; i < 2; ++i) __builtin_amdgcn_global_load_lds((const unsigned*)(Bt + boff[i] + ko), (__attribute__((address_space(3))) unsigned*)(nxt + 16384 + wid * 1024 + i * 4096), 16, 0, 0);
    }
    bf16x8 af[8], bfr[4];
#pragma unroll
    for (int i = 0; i < 8; ++i) af[i] = *(const bf16x8*)(cur + (wm * 8 + i) * 1024 + lo);
#pragma unroll
    for (int j = 0; j < 4; ++j) bfr[j] = *(const bf16x8*)(cur + 16384 + (wn * 4 + j) * 1024 + lo);
    __builtin_amdgcn_sched_barrier(0);
#pragma unroll
    for (int i = 0; i < 8; ++i)
#pragma unroll
      for (int j = 0; j < 4; ++j) acc[i][j] = SWAP ? MFMA16(bfr[j], af[i], acc[i][j]) : MFMA16(af[i], bfr[j], acc[i][j]);
    __builtin_amdgcn_sched_barrier(0);
    WAIT_VM0();
    __syncthreads();
  }
}
DI void zero_acc8(f32x4 (&acc)[8][4]) {
#pragma unroll
  for (int i = 0; i < 8; ++i)
#pragma unroll
    for (int j = 0; j < 4; ++j) acc[i][j] = f32x4{0.f, 0.f, 0.f, 0.f};
}
template <int NJ>
DI void zero_acc(f32x4 (&acc)[4][NJ]) {
#pragma unroll
  for (int i = 0; i < 4; ++i)
#pragma unroll
    for (int j = 0; j < NJ; ++j) acc[i][j] = f32x4{0.f, 0.f, 0.f, 0.f};
}

DI void transpose_tile(const float* __restrict__ W, int K, int N, bf16_t* __restrict__ WT, int tile, float* sm) {
  const int tid = tid_op();
  const int ntn = N >> 6, kt = tile / ntn, nt = tile % ntn;
  __syncthreads();
#pragma unroll
  for (int i = 0; i < 4; ++i) {
    int idx = tid + i * 256, row = idx >> 4, c4 = (idx & 15) * 4;
    float4 v = *(const float4*)(W + (size_t)(kt * 64 + row) * N + nt * 64 + c4);
    sm[row * 65 + c4 + 0] = v.x; sm[row * 65 + c4 + 1] = v.y; sm[row * 65 + c4 + 2] = v.z; sm[row * 65 + c4 + 3] = v.w;
  }
  __syncthreads();
  const int n = tid >> 2, kq = (tid & 3) * 16;
  unsigned pk[8];
#pragma unroll
  for (int i = 0; i < 8; ++i) pk[i] = pack2(sm[(kq + 2 * i) * 65 + n], sm[(kq + 2 * i + 1) * 65 + n]);
  uint4* dst = (uint4*)(WT + (size_t)(nt * 64 + n) * K + kt * 64 + kq);
  dst[0] = uint4{pk[0], pk[1], pk[2], pk[3]};
  dst[1] = uint4{pk[4], pk[5], pk[6], pk[7]};
}

DI void ssm_tables(const Params& p, int layer, int g, float* sm) {
  float* pwr = sm; float* pwi = pwr + 33 * 64; float* bbr = pwi + 33 * 64; float* bbi = bbr + 1024; float* cr = bbi + 1024; float* ci = cr + 1024;
  const int tid = tid_op(), gi = layer * 32 + g;
  unsigned char* tb = ws_op(p) + OFF_SSMT + (size_t)gi * SSMT_STRIDE;
  __syncthreads();
  if (tid < 64) {
    const float a_re = p.in[8][gi * 64 + tid], a_im = p.in[9][gi * 64 + tid];
    const float dt = expf(p.in[10][gi]);
    const float mag = expf(dt * a_re);
    const float abr = mag * cosf(dt * a_im), abi = mag * sinf(dt * a_im);
    const float den = a_re * a_re + a_im * a_im, nr = abr - 1.0f;
    const float cfr = (nr * a_re + abi * a_im) / den, cfi = (abi * a_re - nr * a_im) / den;
    const float* bre = p.in[11] + ((size_t)gi * 64 + tid) * 16;
    const float* bim = p.in[12] + ((size_t)gi * 64 + tid) * 16;
    for (int m = 0; m < 16; ++m) { const float br = bre[m], bi = bim[m]; bbr[tid * 16 + m] = cfr * br - cfi * bi; bbi[tid * 16 + m] = cfr * bi + cfi * br; }
    float pr = 1.0f, pi = 0.0f;
    for (int t = 0; t <= 32; ++t) { pwr[t * 64 + tid] = pr; pwi[t * 64 + tid] = pi; const float nr2 = pr * abr - pi * abi, ni2 = pr * abi + pi * abr; pr = nr2; pi = ni2; }
    float* a32 = (float*)(tb + SSMT_A32);
    a32[tid] = pwr[32 * 64 + tid]; a32[64 + tid] = pwi[32 * 64 + tid];
  }
  for (int idx = tid; idx < 1024; idx += 256) { cr[idx] = p.in[13][(size_t)gi * 1024 + idx]; ci[idx] = p.in[14][(size_t)gi * 1024 + idx]; }
  __syncthreads();
  bf16_t* KT = (bf16_t*)(tb + SSMT_KT); bf16_t* P = (bf16_t*)(tb + SSMT_P); bf16_t* Q = (bf16_t*)(tb + SSMT_Q);
  for (int idx = tid; idx < 33 * 256; idx += 256) {
    const int t1 = idx >> 8, m = (idx >> 4) & 15, mp = idx & 15;
    float acc = 0.f;
    if (t1 > 0) {
      const int t = t1 - 1;
      for (int q = 0; q < 64; ++q) {
        const float ar = pwr[t * 64 + q], ai = pwi[t * 64 + q], br = bbr[q * 16 + mp], bi = bbi[q * 16 + mp];
        acc += cr[m * 64 + q] * (ar * br - ai * bi) - ci[m * 64 + q] * (ar * bi + ai * br);
      }
    }
    KT[idx] = f2bf(acc);
  }
  for (int idx = tid; idx < 128 * 512; idx += 256) {
    const int pp = idx >> 9, k = idx & 511, j = k >> 4, mp = k & 15, q = pp & 63, e = 31 - j;
    const float ar = pwr[e * 64 + q], ai = pwi[e * 64 + q], br = bbr[q * 16 + mp], bi = bbi[q * 16 + mp];
    P[idx] = f2bf(pp < 64 ? (ar * br - ai * bi) : (ar * bi + ai * br));
  }
  for (int idx = tid; idx < 512 * 128; idx += 256) {
    const int row = idx >> 7, pp = idx & 127, i = row >> 4, m = row & 15, q = pp & 63;
    const float ar = pwr[(i + 1) * 64 + q], ai = pwi[(i + 1) * 64 + q], c_r = cr[m * 64 + q], c_i = ci[m * 64 + q];
    Q[idx] = f2bf(pp < 64 ? (c_r * ar - c_i * ai) : (-c_r * ai - c_i * ar));
  }
}

DI void phase_prologue(const Params& p, unsigned char* smem) {
  float* sm = (float*)smem;
  bf16_t* wt = (bf16_t*)(ws_op(p) + OFF_WT);
  const int NT = 2 * 3136 + 512 + 64;
  for (int tt = (int)blockIdx.x; tt < NT; tt += gridDim.x) {
    const int t = tt - 64;
    if (t < 0) ssm_tables(p, tt >> 5, tt & 31, sm);
    else if (t < 2 * 3136) {
      const int layer = t / 3136; int r = t % 3136;
      bf16_t* wl = wt + (size_t)layer * LAYER_W;
      if (r < 2304) transpose_tile(p.in[2] + (size_t)layer * 1024 * 9216, 1024, 9216, wl + W_IN_T, r, sm);
      else if (r < 2368) transpose_tile(p.in[16] + (size_t)layer * 512 * 512, 512, 512, wl + W_GLU_T, r - 2304, sm);
      else if (r < 2624) transpose_tile(p.in[18] + (size_t)layer * 1024 * 1024, 1024, 1024, wl + PA_T, r - 2368, sm);
      else if (r < 2752) transpose_tile(p.in[19] + (size_t)layer * 512 * 1024, 512, 1024, wl + PB_T, r - 2624, sm);
      else if (r < 2880) transpose_tile(p.in[20] + (size_t)layer * 512 * 1024, 512, 1024, wl + PC_T, r - 2752, sm);
      else transpose_tile(p.in[21] + (size_t)layer * 1024 * 1024, 1024, 1024, wl + WO_T, r - 2880, sm);
    } else {
      const int idx = (t - 2 * 3136) * 256 + tid_op();
      const int pos = idx >> 6, i = idx & 63;
      const float inv = exp2f(-(float)i * (13.287712379549449f / 64.0f));
      const float ang = (float)pos * inv;
      float* cosT = (float*)(ws_op(p) + OFF_ROPE); float* sinT = cosT + 2048 * 64;
      cosT[idx] = cosf(ang); sinT[idx] = sinf(ang);
    }
  }
}

DI void phase_norm(const Params& p, int layer, int half) {
  const float* xin = (layer == 0 ? p.in[0] : p.out) + (size_t)half * TH * DM;
  const float* g = p.in[1] + layer * DM;
  bf16_t* h = (bf16_t*)(ws_op(p) + OFF_H);
  const int tid_ = tid_op(), lane = tid_ & 63, wave = tid_ >> 6;
  for (int row = (int)blockIdx.x * 4 + wave; row < TH; row += gridDim.x * 4) {
    const float* xr = xin + (size_t)row * DM;
    float4 v[4]; float ss = 0.f;
#pragma unroll
    for (int i = 0; i < 4; ++i) { v[i] = *(const float4*)(xr + (i >> 1) * 512 + lane * 8 + (i & 1) * 4); ss += v[i].x * v[i].x + v[i].y * v[i].y + v[i].z * v[i].z + v[i].w * v[i].w; }
#pragma unroll
    for (int o = 32; o >= 1; o >>= 1) ss += shx(ss, o, lane);
    const float rstd = rsqrtf(ss * (1.0f / 1024.0f) + EPS);
#pragma unroll
    for (int i2 = 0; i2 < 2; ++i2) {
      const int c0 = i2 * 512 + lane * 8;
      const float4 ga = *(const float4*)(g + c0), gb = *(const float4*)(g + c0 + 4);
      const float4 va = v[2 * i2], vb = v[2 * i2 + 1];
      u32x4 o4;
      o4[0] = pack2(va.x * rstd * ga.x, va.y * rstd * ga.y); o4[1] = pack2(va.z * rstd * ga.z, va.w * rstd * ga.w);
      o4[2] = pack2(vb.x * rstd * gb.x, vb.y * rstd * gb.y); o4[3] = pack2(vb.z * rstd * gb.z, vb.w * rstd * gb.w);
      *(u32x4*)(h + (size_t)row * DM + c0) = o4;
    }
  }
}

DI void phase_inproj(const Params& p, int layer, unsigned char* smem) {
  const bf16_t* h = (const bf16_t*)(ws_op(p) + OFF_H);
  const bf16_t* WinT = (const bf16_t*)(ws_op(p) + OFF_WT) + (size_t)layer * LAYER_W + W_IN_T;
  bf16_t* proj = (bf16_t*)(ws_op(p) + OFF_PROJ);
  bf16_t* rvt = (bf16_t*)(ws_op(p) + OFF_RVT);
  bf16_t* svt = (bf16_t*)(ws_op(p) + OFF_SVT);
  const int tid_ = tid_op(), lane = tid_ & 63, wave = tid_ >> 6, wm = wave >> 1, wn = wave & 1;
  bool pre = false;
  for (int t = (int)blockIdx.x; t < 128 * 72; t += gridDim.x) {
    const int mt = t / 72, nt = t % 72, m0 = mt * 128, n0 = nt * 128;
    f32x4 acc[4][4]; zero_acc<4>(acc);
    const bool isrv = (n0 >= 1024 && n0 < 2048), issv = (n0 >= 4096 && n0 < 4608);
    const int tn = t + (int)gridDim.x;
    const bool chain = (tn < 128 * 72) && (isrv || issv || n0 >= 1024);
    const bf16_t* An = h + (size_t)((tn / 72) * 128) * DM; const bf16_t* Bn = WinT + (size_t)((tn % 72) * 128) * DM;
    if (isrv || issv) {
      gemm_core<false, 4>(h + (size_t)m0 * DM, DM, WinT + (size_t)n0 * DM, DM, DM, acc, smem, pre);
      pre = chain;
      if (chain) gemm_issue0(An, DM, Bn, DM, smem);
#pragma unroll
      for (int i = 0; i < 4; i += 2)
#pragma unroll
        for (int j = 0; j < 4; ++j) {
          const int mb = m0 + wm * 64 + i * 16, n = n0 + wn * 64 + j * 16 + (lane & 15);
          const int bl = mb >> 11, s = mb & 2047;
          uint2 oa, ob;
          oa.x = pack2(acc[i][j][0], acc[i][j][1]); oa.y = pack2(acc[i][j][2], acc[i][j][3]);
          ob.x = pack2(acc[i + 1][j][0], acc[i + 1][j][1]); ob.y = pack2(acc[i + 1][j][2], acc[i + 1][j][3]);
          bf16_t* rowp;
          if (isrv) { const int c = n - 1024, hh = c >> 8, dv = c & 255; rowp = rvt + ((size_t)((bl * 4 + hh) * 256 + dv)) * 2048 + s; }
          else { const int c = n - 4096, hh = c >> 6, dv = c & 63; rowp = svt + ((size_t)((bl * 8 + hh) * 64 + dv)) * 2048 + s; }
          store16_pair(rowp, oa, ob, lane >> 4);
        }
    } else {
      gemm_core<true, 4>(h + (size_t)m0 * DM, DM, WinT + (size_t)n0 * DM, DM, DM, acc, smem, pre);
      pre = chain;
      if (chain) gemm_issue0(An, DM, Bn, DM, smem);
      const int shift = (n0 >= 2048 ? 1024 : 0) + (n0 >= 4608 ? 512 : 0);
      const int fr = lane & 15, kq = lane >> 4;
      if (n0 >= 3072 && n0 < 4096) {
        const bool isq = n0 < 3584;
        const float* gain = (isq ? p.in[6] : p.in[7]) + layer * 64;
#pragma unroll
        for (int i = 0; i < 4; ++i) {
          float ss = 0.f;
#pragma unroll
          for (int j = 0; j < 4; ++j) ss += acc[i][j][0] * acc[i][j][0] + acc[i][j][1] * acc[i][j][1] + acc[i][j][2] * acc[i][j][2] + acc[i][j][3] * acc[i][j][3];
          ss += shx(ss, 16, lane); ss += shx(ss, 32, lane);
          const float rs = rsqrtf(ss * (1.0f / 64.0f) + EPS) * (isq ? 0.125f : 1.0f);
#pragma unroll
          for (int j = 0; j < 4; ++j) { const float4 g4 = *(const float4*)(gain + j * 16 + kq * 4); acc[i][j][0] *= rs * g4.x; acc[i][j][1] *= rs * g4.y; acc[i][j][2] *= rs * g4.z; acc[i][j][3] *= rs * g4.w; }
        }
      } else if (n0 < 1024) {
        const bool isq = n0 < 512;
        const int hk = (n0 & 511) >> 7;
        const float* gain = (isq ? p.in[3] : p.in[4]) + layer * 128 + wn * 64;
        float* xv = (float*)smem;
        float* ssx = (float*)(smem + 65600);
        const float* cosT = (const float*)(ws_op(p) + OFF_ROPE); const float* sinT = cosT + 2048 * 64;
        float ssp[4];
#pragma unroll
        for (int i = 0; i < 4; ++i) {
          float ss = 0.f;
#pragma unroll
          for (int j = 0; j < 4; ++j) ss += acc[i][j][0] * acc[i][j][0] + acc[i][j][1] * acc[i][j][1] + acc[i][j][2] * acc[i][j][2] + acc[i][j][3] * acc[i][j][3];
          ss += shx(ss, 16, lane); ss += shx(ss, 32, lane);
          ssp[i] = ss;
          if (kq == 0) ssx[wave * 64 + i * 16 + fr] = ss;
        }
        __syncthreads();
#pragma unroll
        for (int i = 0; i < 4; ++i) {
          const float rs = rsqrtf((ssp[i] + ssx[(wave ^ 1) * 64 + i * 16 + fr]) * (1.0f / 128.0f) + EPS);
#pragma unroll
          for (int j = 0; j < 4; ++j) {
            const float4 g4 = *(const float4*)(gain + j * 16 + kq * 4);
            acc[i][j][0] *= rs * g4.x; acc[i][j][1] *= rs * g4.y; acc[i][j][2] *= rs * g4.z; acc[i][j][3] *= rs * g4.w;
#pragma unroll
            for (int r = 0; r < 4; ++r) xv[wave * 4096 + ((i * 4 + j) * 4 + r) * 64 + lane] = acc[i][j][r];
          }
        }
        __syncthreads();
        const float sgn = wn ? 1.0f : -1.0f, ksc = isq ? 1.0f : 0.08838834764831845f;
        const float lg2k = log2f(1.0f - exp2f(-5.0f - (float)hk));
#pragma unroll
        for (int i = 0; i < 4; ++i) {
          const int m = m0 + wm * 64 + i * 16 + fr, pos = m & 2047;
          const float kd = exp2f((float)(127 - (pos & 127)) * lg2k);
          bf16_t* kdst = (bf16_t*)(ws_op(p) + OFF_KDT) + ((size_t)(((m >> 11) * 4 + hk) * 128 + wn * 64)) * 2048 + pos;
#pragma unroll
          for (int j = 0; j < 4; ++j) {
            const float4 c4 = *(const float4*)(cosT + pos * 64 + j * 16 + kq * 4), s4 = *(const float4*)(sinT + pos * 64 + j * 16 + kq * 4);
            const float cc[4] = {c4.x, c4.y, c4.z, c4.w}, sn[4] = {s4.x, s4.y, s4.z, s4.w};
#pragma unroll
            for (int r = 0; r < 4; ++r) {
              const float other = xv[(wave ^ 1) * 4096 + ((i * 4 + j) * 4 + r) * 64 + lane];
              const float o = (acc[i][j][r] * cc[r] + sgn * other * sn[r]) * ksc;
              acc[i][j][r] = o;
              if (!isq) kdst[(size_t)(j * 16 + kq * 4 + r) * 2048] = f2bf(o * kd);
            }
          }
#pragma unroll
          for (int j = 0; j < 4; j += 2) {
            uint2 oa, ob;
            oa.x = pack2(acc[i][j][0], acc[i][j][1]); oa.y = pack2(acc[i][j][2], acc[i][j][3]);
            ob.x = pack2(acc[i][j + 1][0], acc[i][j + 1][1]); ob.y = pack2(acc[i][j + 1][2], acc[i][j + 1][3]);
            store16_pair(proj + (size_t)m * PS + n0 + wn * 64 + j * 16, oa, ob, kq);
          }
        }
        continue;
      }
#pragma unroll
      for (int i = 0; i < 4; ++i)
#pragma unroll
        for (int j = 0; j < 4; j += 2) {
          const int m = m0 + wm * 64 + i * 16 + (lane & 15);
          uint2 oa, ob;
          oa.x = pack2(acc[i][j][0], acc[i][j][1]); oa.y = pack2(acc[i][j][2], acc[i][j][3]);
          ob.x = pack2(acc[i][j + 1][0], acc[i][j + 1][1]); ob.y = pack2(acc[i][j + 1][2], acc[i][j + 1][3]);
          store16_pair(proj + (size_t)m * PS + n0 - shift + wn * 64 + j * 16, oa, ob, lane >> 4);
        }
    }
  }
}

DI bf16x8 pack_frag(const f32x16& x, int s) {
  u32x4 p;
  asm volatile("v_cvt_pk_bf16_f32 %0, %4, %5\n\tv_cvt_pk_bf16_f32 %1, %6, %7\n\tv_cvt_pk_bf16_f32 %2, %8, %9\n\tv_cvt_pk_bf16_f32 %3, %10, %11\n\ts_nop 1"
               : "=&v"(p[0]), "=&v"(p[1]), "=&v"(p[2]), "=&v"(p[3])
               : "v"(x[8 * s]), "v"(x[8 * s + 1]), "v"(x[8 * s + 2]), "v"(x[8 * s + 3]), "v"(x[8 * s + 4]), "v"(x[8 * s + 5]), "v"(x[8 * s + 6]), "v"(x[8 * s + 7]));
  return __builtin_bit_cast(bf16x8, p);
}

DI void sb_item(const Params& p, int b, int h, int qi, unsigned char* smem) {
  bf16_t* Ks = (bf16_t*)smem;
  bf16_t* Vt = Ks + 128 * 72;
  const bf16_t* proj = (const bf16_t*)(ws_op(p) + OFF_PROJ);
  const bf16_t* svt = (const bf16_t*)(ws_op(p) + OFF_SVT);
  bf16_t* yb = (bf16_t*)(ws_op(p) + OFF_YB);
  const int tid = tid_op(), lane = tid & 63, wave = tid >> 6, r = lane & 31, h2 = lane >> 5;
  const int qpos = qi * 128 + wave * 32 + r;
  const size_t mq = (size_t)b * 2048 + qpos;
  bf16x8 qf[4];
#pragma unroll
  for (int ks = 0; ks < 4; ++ks) qf[ks] = *(const bf16x8*)(proj + mq * PS + C_SQ + h * 64 + ks * 16 + h2 * 8);
  f32x16 o[2];
#pragma unroll
  for (int i = 0; i < 16; ++i) { o[0][i] = 0.f; o[1][i] = 0.f; }
  float carry = 1.0f;
  u32x4 pk[4], pv[4];
#pragma unroll
  for (int i = 0; i < 4; ++i) {
    const int c = tid + i * 256;
    pk[i] = *(const u32x4*)(proj + ((size_t)b * 2048 + qi * 128 + (c >> 3)) * PS + C_SK + h * 64 + (c & 7) * 8);
    pv[i] = *(const u32x4*)(svt + ((size_t)((b * 8 + h) * 64 + (c >> 4))) * 2048 + qi * 128 + (c & 15) * 8);
  }
  for (int kb = qi; kb >= 0; --kb) {
    __syncthreads();
    if (kb != qi) { const volatile int* vote = (const volatile int*)(smem + 65568); if (vote[0] & vote[1] & vote[2] & vote[3]) break; }
#pragma unroll
    for (int i = 0; i < 4; ++i) {
      const int c = tid + i * 256;
      *(u32x4*)(Ks + (c >> 3) * 72 + (c & 7) * 8) = pk[i];
      *(u32x4*)(Vt + (c >> 4) * 136 + (c & 15) * 8) = pv[i];
    }
    __syncthreads();
    if (kb > 0) {
#pragma unroll
      for (int i = 0; i < 4; ++i) {
        const int c = tid + i * 256;
        pk[i] = *(const u32x4*)(proj + ((size_t)b * 2048 + (kb - 1) * 128 + (c >> 3)) * PS + C_SK + h * 64 + (c & 7) * 8);
        pv[i] = *(const u32x4*)(svt + ((size_t)((b * 8 + h) * 64 + (c >> 4))) * 2048 + (kb - 1) * 128 + (c & 15) * 8);
      }
    }
    const bool diag = (kb == qi);
    for (int kt = 3; kt >= 0; --kt) {
      f32x16 s;
#pragma unroll
      for (int i = 0; i < 16; ++i) s[i] = 0.f;
#pragma unroll
      for (int ks = 0; ks < 4; ++ks) { bf16x8 kf = *(const bf16x8*)(Ks + (kt * 32 + r) * 72 + ks * 16 + h2 * 8); s = MFMA32(kf, qf[ks], s); }
      const int keybase = kb * 128 + kt * 32 + 4 * h2;
      float kp[16];
#pragma unroll
      for (int reg = 0; reg < 16; ++reg) {
        kp[reg] = __builtin_amdgcn_rcpf(1.0f + __expf(s[reg]));
        if (diag) { const int key = keybase + (reg & 3) + 8 * (reg >> 2); kp[reg] = (key < qpos) ? kp[reg] : 1.0f; }
      }
      float G[4], Gp[4], off[4];
#pragma unroll
      for (int g = 0; g < 4; ++g) { G[g] = (kp[4 * g] * kp[4 * g + 1]) * (kp[4 * g + 2] * kp[4 * g + 3]); Gp[g] = shx(G[g], 32, lane); }
      const float T0 = G[0] * Gp[0], T1 = G[1] * Gp[1], T2 = G[2] * Gp[2], T3 = G[3] * Gp[3];
      const float st2 = T3, st1 = T3 * T2, st0 = st1 * T1, total = st0 * T0;
      off[3] = carry; off[2] = carry * st2; off[1] = carry * st1; off[0] = carry * st0;
      if (h2 == 0) { off[0] *= Gp[0]; off[1] *= Gp[1]; off[2] *= Gp[2]; off[3] *= Gp[3]; }
      f32x16 w;
#pragma unroll
      for (int g = 0; g < 4; ++g) {
        float e = off[g];
#pragma unroll
        for (int i = 3; i >= 0; --i) {
          const int reg = 4 * g + i;
          w[reg] = (1.0f - kp[reg]) * e;
          e *= kp[reg];
        }
      }
      carry *= total;
#pragma unroll
      for (int sidx = 0; sidx < 2; ++sidx) {
        const bf16x8 pf = pack_frag(w, sidx);
#pragma unroll
        for (int dt = 0; dt < 2; ++dt) {
          const bf16_t* vp = Vt + (dt * 32 + r) * 136 + kt * 32 + 16 * sidx + 4 * h2;
          const s16x4 lo = *(const s16x4*)vp, hi = *(const s16x4*)(vp + 8);
          const bf16x8 vf = __builtin_shufflevector(lo, hi, 0, 1, 2, 3, 4, 5, 6, 7);
          o[dt] = MFMA32(vf, pf, o[dt]);
        }
      }
    }
    { const int alld = __all(carry < 1e-37f); if (lane == 0) ((volatile int*)(smem + 65568))[wave] = alld ? 1 : 0; }
  }
#pragma unroll
  for (int dt = 0; dt < 2; ++dt)
#pragma unroll
    for (int gp = 0; gp < 4; gp += 2) {
      uint2 zq[2], oq[2];
      load32_pair(proj + mq * PS + C_SZ + h * 64 + dt * 32 + 8 * gp, zq[0], zq[1], h2);
#pragma unroll
      for (int q = 0; q < 2; ++q) {
        const int g = gp + q; const uint2 zz = zq[q];
        const float z0 = bf2f((bf16_t)(zz.x & 0xffff)), z1 = bf2f((bf16_t)(zz.x >> 16)), z2 = bf2f((bf16_t)(zz.y & 0xffff)), z3 = bf2f((bf16_t)(zz.y >> 16));
        oq[q].x = pack2(o[dt][4 * g] * siluf_(z0), o[dt][4 * g + 1] * siluf_(z1)); oq[q].y = pack2(o[dt][4 * g + 2] * siluf_(z2), o[dt][4 * g + 3] * siluf_(z3));
      }
      store32_pair(yb + mq * 512 + h * 64 + dt * 32 + 8 * gp, oq[0], oq[1], h2);
    }
}

DI void ret_item(const Params& p, int b, int h, int es, int part, unsigned char* smem) {
  bf16_t* Ks = (bf16_t*)smem;
  bf16_t* Vt = Ks + 64 * 136;
  bf16_t* St = Vt + 64 * 136;
  const bf16_t* proj = (const bf16_t*)(ws_op(p) + OFF_PROJ);
  const bf16_t* rvt = (const bf16_t*)(ws_op(p) + OFF_RVT);
  const bf16_t* kdt = (const bf16_t*)(ws_op(p) + OFF_KDT);
  bf16_t* ya = (bf16_t*)(ws_op(p) + OFF_YA);
  float* ssq = (float*)(ws_op(p) + OFF_SSQ);
  const int tid = tid_op(), lane = tid & 63, wave = tid >> 6, r = lane & 31, h2 = lane >> 5;
  const float lg2 = log2f(1.0f - exp2f(-5.0f - (float)h));
  const float cdec = exp2f(128.0f * lg2);
  const int il = wave * 32 + r;
  const float qdec = exp2f((float)(il + 1) * lg2);
  f32x16 st[2];
#pragma unroll
  for (int i = 0; i < 16; ++i) { st[0][i] = 0.f; st[1][i] = 0.f; }
  const size_t vrow0 = (size_t)((b * 4 + h) * 256 + es * 64);
  const size_t krow = (size_t)((b * 4 + h) * 128 + wave * 32 + r);
  const int srow = tid >> 4, skc = (tid & 15) * 8;
  if (part) {
    for (int n = 0; n < 8; ++n) {
      bf16x8 kdf[8];
#pragma unroll
      for (int ks = 0; ks < 8; ++ks) kdf[ks] = *(const bf16x8*)(kdt + krow * 2048 + n * 128 + ks * 16 + h2 * 8);
      __syncthreads();
#pragma unroll
      for (int i = 0; i < 4; ++i) { const int row = srow + i * 16; *(u32x4*)(Vt + row * 136 + skc) = *(const u32x4*)(rvt + (vrow0 + row) * 2048 + n * 128 + skc); }
      __syncthreads();
#pragma unroll
      for (int i = 0; i < 16; ++i) { st[0][i] *= cdec; st[1][i] *= cdec; }
#pragma unroll
      for (int ks = 0; ks < 8; ++ks)
#pragma unroll
        for (int et = 0; et < 2; ++et) { const bf16x8 vf = *(const bf16x8*)(Vt + (et * 32 + r) * 136 + ks * 16 + h2 * 8); st[et] = MFMA32(vf, kdf[ks], st[et]); }
    }
  }
  for (int n = part * 8; n < part * 8 + 8; ++n) {
    const size_t mq = (size_t)b * 2048 + n * 128 + il;
    bf16x8 qf[8];
#pragma unroll
    for (int ks = 0; ks < 8; ++ks) qf[ks] = *(const bf16x8*)(proj + mq * PS + C_RQ + h * 128 + ks * 16 + h2 * 8);
    __syncthreads();
#pragma unroll
    for (int et = 0; et < 2; ++et)
#pragma unroll
      for (int reg = 0; reg < 16; ++reg) St[(et * 32 + crow(reg, h2)) * 136 + wave * 32 + r] = f2bf(st[et][reg]);
#pragma unroll
    for (int i = 0; i < 4; ++i) {
      const int row = srow + i * 16;
      *(u32x4*)(Vt + row * 136 + skc) = *(const u32x4*)(rvt + (vrow0 + row) * 2048 + n * 128 + skc);
      *(u32x4*)(Ks + row * 136 + skc) = *(const u32x4*)(proj + ((size_t)b * 2048 + n * 128 + row) * PS + C_RK + h * 128 + skc);
    }
    __syncthreads();
    f32x16 o[2];
#pragma unroll
    for (int i = 0; i < 16; ++i) { o[0][i] = 0.f; o[1][i] = 0.f; }
#pragma unroll
    for (int ks = 0; ks < 8; ++ks)
#pragma unroll
      for (int et = 0; et < 2; ++et) { const bf16x8 sf = *(const bf16x8*)(St + (et * 32 + r) * 136 + ks * 16 + h2 * 8); o[et] = MFMA32(sf, qf[ks], o[et]); }
#pragma unroll
    for (int i = 0; i < 16; ++i) { o[0][i] *= qdec; o[1][i] *= qdec; }
    for (int jh = 0; jh < 2; ++jh) {
      if (jh) {
        __syncthreads();
#pragma unroll
        for (int i = 0; i < 4; ++i) {
          const int row = srow + i * 16;
          *(u32x4*)(Ks + row * 136 + skc) = *(const u32x4*)(proj + ((size_t)b * 2048 + n * 128 + 64 + row) * PS + C_RK + h * 128 + skc);
        }
        __syncthreads();
      }
      for (int kt = 0; kt < 2; ++kt) {
        const int key0 = jh * 64 + kt * 32;
        if (key0 > wave * 32 + 31) continue;
        f32x16 s;
#pragma unroll
        for (int i = 0; i < 16; ++i) s[i] = 0.f;
#pragma unroll
        for (int ks = 0; ks < 8; ++ks) { const bf16x8 kf = *(const bf16x8*)(Ks + (kt * 32 + r) * 136 + ks * 16 + h2 * 8); s = MFMA32(kf, qf[ks], s); }
#pragma unroll
        for (int reg = 0; reg < 16; ++reg) {
          const int dl = il - (key0 + crow(reg, h2));
          s[reg] = (dl >= 0) ? s[reg] * __builtin_amdgcn_exp2f((float)dl * lg2) : 0.f;
        }
#pragma unroll
        for (int sidx = 0; sidx < 2; ++sidx) {
          const bf16x8 pf = pack_frag(s, sidx);
#pragma unroll
          for (int et = 0; et < 2; ++et) {
            const bf16_t* vp = Vt + (et * 32 + r) * 136 + key0 + 16 * sidx + 4 * h2;
            const s16x4 lo = *(const s16x4*)vp, hi = *(const s16x4*)(vp + 8);
            const bf16x8 vf = __builtin_shufflevector(lo, hi, 0, 1, 2, 3, 4, 5, 6, 7);
            o[et] = MFMA32(vf, pf, o[et]);
          }
        }
      }
    }
    bf16x8 kdf[8];
#pragma unroll
    for (int ks = 0; ks < 8; ++ks) kdf[ks] = *(const bf16x8*)(kdt + krow * 2048 + n * 128 + ks * 16 + h2 * 8);
    float ss = 0.f;
#pragma unroll
    for (int i = 0; i < 16; ++i) ss += o[0][i] * o[0][i] + o[1][i] * o[1][i];
    ss += shx(ss, 32, lane);
    if (h2 == 0) ssq[mq * 16 + h * 4 + es] = ss;
#pragma unroll
    for (int et = 0; et < 2; ++et)
#pragma unroll
      for (int g = 0; g < 4; g += 2) {
        uint2 oa, ob;
        oa.x = pack2(o[et][4 * g], o[et][4 * g + 1]); oa.y = pack2(o[et][4 * g + 2], o[et][4 * g + 3]);
        ob.x = pack2(o[et][4 * g + 4], o[et][4 * g + 5]); ob.y = pack2(o[et][4 * g + 6], o[et][4 * g + 7]);
        store32_pair(ya + mq * 1024 + h * 256 + es * 64 + et * 32 + 8 * g, oa, ob, h2);
      }
#pragma unroll
    for (int i = 0; i < 16; ++i) { st[0][i] *= cdec; st[1][i] *= cdec; }
#pragma unroll
    for (int ks = 0; ks < 8; ++ks)
#pragma unroll
      for (int et = 0; et < 2; ++et) { const bf16x8 vf = *(const bf16x8*)(Vt + (et * 32 + r) * 136 + ks * 16 + h2 * 8); st[et] = MFMA32(vf, kdf[ks], st[et]); }
  }
}

DI void ret_finalize(const Params& p, int layer) {
  const bf16_t* proj = (const bf16_t*)(ws_op(p) + OFF_PROJ);
  bf16_t* ya = (bf16_t*)(ws_op(p) + OFF_YA);
  const float* ssq = (const float*)(ws_op(p) + OFF_SSQ);
  const float* gn = p.in[5] + layer * 1024;
  const int tid = tid_op();
  for (int idx = (int)blockIdx.x * 256 + tid; idx < TH * 128; idx += gridDim.x * 256) {
    const size_t tok = idx >> 7; const int c8 = (idx & 127) * 8, head = c8 >> 8;
    const float4 s4 = *(const float4*)(ssq + tok * 16 + head * 4);
    const float rstd = rsqrtf((s4.x + s4.y + s4.z + s4.w) * (1.0f / 256.0f) + EPS);
    const u32x4 ov = *(const u32x4*)(ya + tok * 1024 + c8);
    const u32x4 zv = *(const u32x4*)(proj + tok * PS + C_RZ + c8);
    const float4 g0 = *(const float4*)(gn + c8), g1 = *(const float4*)(gn + c8 + 4);
    const float gg[8] = {g0.x, g0.y, g0.z, g0.w, g1.x, g1.y, g1.z, g1.w};
    u32x4 res;
#pragma unroll
    for (int q = 0; q < 4; ++q) {
      const float o0 = bf2f((bf16_t)(ov[q] & 0xffff)), o1 = bf2f((bf16_t)(ov[q] >> 16));
      const float z0 = bf2f((bf16_t)(zv[q] & 0xffff)), z1 = bf2f((bf16_t)(zv[q] >> 16));
      res[q] = pack2(o0 * rstd * gg[2 * q] * siluf_(z0), o1 * rstd * gg[2 * q + 1] * siluf_(z1));
    }
    *(u32x4*)(ya + tok * 1024 + c8) = res;
  }
}

DI void ssm_item(const Params& p, int layer, int b, int g, unsigned char* smem) {
  float* Ss = (float*)smem;
  bf16_t* KTs = (bf16_t*)smem;
  bf16_t* Hp = (bf16_t*)(smem + 33792);
  const bf16_t* proj = (const bf16_t*)(ws_op(p) + OFF_PROJ);
  bf16_t* ycp = (bf16_t*)(ws_op(p) + OFF_YCP);
  const int gi = layer * 32 + g;
  const unsigned char* tb = ws_op(p) + OFF_SSMT + (size_t)gi * SSMT_STRIDE;
  const bf16_t* KTg = (const bf16_t*)(tb + SSMT_KT); const bf16_t* Pg = (const bf16_t*)(tb + SSMT_P); const bf16_t* Qg = (const bf16_t*)(tb + SSMT_Q);
  const float* a32 = (const float*)(tb + SSMT_A32);
  const int tid = tid_op(), lane = tid & 63, wave = tid >> 6, fr = lane & 15, kq = lane >> 4;
  const int chunk = wave * 16 + fr;
  const bf16_t* ubase = proj + ((size_t)b * 2048 + chunk * 32 + (kq >> 1)) * PS + C_CU + g * 16 + 8 * (kq & 1);
  bf16x8 ub[16];
#pragma unroll
  for (int jp = 0; jp < 16; ++jp) ub[jp] = *(const bf16x8*)(ubase + (size_t)(2 * jp) * PS);
  __syncthreads();
#pragma unroll 1
  for (int mt = 0; mt < 8; ++mt) {
    f32x4 acc = {0.f, 0.f, 0.f, 0.f};
    const bf16_t* prow = Pg + (size_t)(mt * 16 + fr) * 512 + kq * 8;
#pragma unroll
    for (int ks = 0; ks < 16; ++ks) { const bf16x8 pf = *(const bf16x8*)(prow + ks * 32); acc = MFMA16(pf, ub[ks], acc); }
    *(f32x4*)(Ss + chunk * 132 + mt * 16 + kq * 4) = acc;
  }
  __syncthreads();
  if (wave == 0) {
    const float ar = a32[lane], ai = a32[64 + lane];
    float hr = 0.f, hi = 0.f;
    for (int c = 0; c < 64; ++c) {
      Hp[c * 136 + lane] = f2bf(hr); Hp[c * 136 + 64 + lane] = f2bf(hi);
      const float sr = Ss[c * 132 + lane], si = Ss[c * 132 + 64 + lane];
      const float nr = ar * hr - ai * hi + sr, ni = ar * hi + ai * hr + si;
      hr = nr; hi = ni;
    }
  }
  __syncthreads();
  for (int c = tid; c < 1056; c += 256) *(u32x4*)(KTs + c * 8) = *(const u32x4*)(KTg + c * 8);
  __syncthreads();
  float dsk[4];
#pragma unroll
  for (int i = 0; i < 4; ++i) dsk[i] = p.in[15][layer * 512 + g * 16 + kq * 4 + i];
  const int th = kq >> 1;
  const bf16_t* ktl = KTs + fr * 16 + 8 * (kq & 1);
#pragma unroll 1
  for (int ih = 0; ih < 2; ++ih) {
    f32x4 acc[16];
#pragma unroll
    for (int ii = 0; ii < 16; ++ii) {
      acc[ii] = f32x4{0.f, 0.f, 0.f, 0.f};
      const bf16_t* qrow = Qg + (size_t)((ih * 16 + ii) * 16 + fr) * 128 + kq * 8;
#pragma unroll
      for (int ks = 0; ks < 4; ++ks) { const bf16x8 qf = *(const bf16x8*)(qrow + ks * 32); const bf16x8 hbk = *(const bf16x8*)(Hp + chunk * 136 + ks * 32 + kq * 8); acc[ii] = MFMA16(qf, hbk, acc[ii]); }
    }
    if (ih == 0) {
#pragma unroll
      for (int ii = 0; ii < 16; ++ii)
#pragma unroll
        for (int jp = 0; jp <= (ii >> 1); ++jp) {
          const int t1 = ii - 2 * jp - th + 1;
          const bf16x8 kf = *(const bf16x8*)(ktl + t1 * 256);
          acc[ii] = MFMA16(kf, ub[jp], acc[ii]);
        }
    } else {
#pragma unroll
      for (int ii = 0; ii < 16; ++ii)
#pragma unroll
        for (int jp = 0; jp <= ((16 + ii) >> 1); ++jp) {
          const int t1 = 16 + ii - 2 * jp - th + 1;
          const bf16x8 kf = *(const bf16x8*)(ktl + t1 * 256);
          acc[ii] = MFMA16(kf, ub[jp], acc[ii]);
        }
    }
#pragma unroll
    for (int ii = 0; ii < 16; ii += 2) {
      const size_t tok = (size_t)b * 2048 + chunk * 32 + ih * 16 + ii;
      uint2 uq[2], oq[2];
      load16_pair(proj + tok * PS + C_CU + g * 16, uq[0], uq[1], kq, PS);
#pragma unroll
      for (int q = 0; q < 2; ++q) {
        const uint2 uu = uq[q];
        const float y0 = gelu_tanh(acc[ii + q][0] + dsk[0] * bf2f((bf16_t)(uu.x & 0xffff)));
        const float y1 = gelu_tanh(acc[ii + q][1] + dsk[1] * bf2f((bf16_t)(uu.x >> 16)));
        const float y2 = gelu_tanh(acc[ii + q][2] + dsk[2] * bf2f((bf16_t)(uu.y & 0xffff)));
        const float y3 = gelu_tanh(acc[ii + q][3] + dsk[3] * bf2f((bf16_t)(uu.y >> 16)));
        oq[q].x = pack2(y0, y1); oq[q].y = pack2(y2, y3);
      }
      store16_pair(ycp + tok * 512 + g * 16, oq[0], oq[1], kq, 512);
    }
  }
}

DI void phase_mixers(const Params& p, int layer, int half, unsigned char* smem) {
  const int NI = 256 + 256 + 1024;
  int* ctr = (int*)(ws_op(p) + OFF_CTR) + (layer * 2 + half);
  int* s_item = (int*)(smem + 65536);
  const int tid = tid_op();
  for (;;) {
    __syncthreads();
    if (tid == 0) *s_item = atomicAdd(ctr, 1);
    __syncthreads();
    const int id = *s_item;
    if (id >= NI) break;
    if (id < 256) ssm_item(p, layer, id >> 5, id & 31, smem);
    else if (id < 512) { const int j = id - 256, q = j & 127; ret_item(p, q >> 4, (q >> 2) & 3, q & 3, 1 - (j >> 7), smem); }
    else { const int j = id - 512, r = j & 63; sb_item(p, r >> 3, r & 7, 15 - (j >> 6), smem); }
  }
}

DI void phase_glu(const Params& p, int layer, unsigned char* smem) {
  const bf16_t* ycp = (const bf16_t*)(ws_op(p) + OFF_YCP);
  const bf16_t* WT = (const bf16_t*)(ws_op(p) + OFF_WT) + (size_t)layer * LAYER_W + W_GLU_T;
  const bf16_t* proj = (const bf16_t*)(ws_op(p) + OFF_PROJ);
  bf16_t* yc = (bf16_t*)(ws_op(p) + OFF_YC);
  const float* bg = p.in[17] + layer * 512;
  const int tid_ = tid_op(), lane = tid_ & 63, wave = tid_ >> 6, wm = wave >> 1, wn = wave & 1;
  for (int t = (int)blockIdx.x; t < 128 * 4; t += gridDim.x) {
    const int m0 = (t >> 2) * 128, n0 = (t & 3) * 128;
    f32x4 acc[4][4]; zero_acc<4>(acc);
    gemm_core<true, 4>(ycp + (size_t)m0 * 512, 512, WT + (size_t)n0 * 512, 512, 512, acc, smem);
#pragma unroll
    for (int i = 0; i < 4; ++i)
#pragma unroll
      for (int jp = 0; jp < 4; jp += 2) {
        const size_t m = m0 + wm * 64 + i * 16 + (lane & 15); const int nb = n0 + wn * 64 + jp * 16;
        uint2 yq[2], zq[2], oq[2];
        load16_pair(ycp + m * 512 + nb, yq[0], yq[1], lane >> 4);
        load16_pair(proj + m * PS + C_CZ + nb, zq[0], zq[1], lane >> 4);
#pragma unroll
        for (int q = 0; q < 2; ++q) {
          const int j = jp + q; const uint2 yy = yq[q], zz = zq[q];
          const float4 b4 = *(const float4*)(bg + nb + q * 16 + (lane >> 4) * 4);
          const float y0 = bf2f((bf16_t)(yy.x & 0xffff)), y1 = bf2f((bf16_t)(yy.x >> 16)), y2 = bf2f((bf16_t)(yy.y & 0xffff)), y3 = bf2f((bf16_t)(yy.y >> 16));
          const float z0 = bf2f((bf16_t)(zz.x & 0xffff)), z1 = bf2f((bf16_t)(zz.x >> 16)), z2 = bf2f((bf16_t)(zz.y & 0xffff)), z3 = bf2f((bf16_t)(zz.y >> 16));
          oq[q].x = pack2(y0 * sigmoidf_(acc[i][j][0] + b4.x) * siluf_(z0), y1 * sigmoidf_(acc[i][j][1] + b4.y) * siluf_(z1));
          oq[q].y = pack2(y2 * sigmoidf_(acc[i][j][2] + b4.z) * siluf_(z2), y3 * sigmoidf_(acc[i][j][3] + b4.w) * siluf_(z3));
        }
        store16_pair(yc + m * 512 + nb, oq[0], oq[1], lane >> 4);
      }
  }
}

DI void phase_merge(const Params& p, int layer, unsigned char* smem) {
  const bf16_t* wl = (const bf16_t*)(ws_op(p) + OFF_WT) + (size_t)layer * LAYER_W;
  const bf16_t* ya = (const bf16_t*)(ws_op(p) + OFF_YA);
  const bf16_t* yb = (const bf16_t*)(ws_op(p) + OFF_YB);
  const bf16_t* yc = (const bf16_t*)(ws_op(p) + OFF_YC);
  const bf16_t* proj = (const bf16_t*)(ws_op(p) + OFF_PROJ);
  bf16_t* merged = (bf16_t*)(ws_op(p) + OFF_H);
  const int tid_ = tid_op(), lane = tid_ & 63, wave = tid_ >> 6, wm = wave >> 1, wn = wave & 1;
  for (int t = (int)blockIdx.x; t < 128 * 8; t += gridDim.x) {
    const int m0 = (t >> 3) * 128, n0 = (t & 7) * 128;
    f32x4 mg[4][4]; zero_acc<4>(mg);
#pragma unroll 1
    for (int br = 0; br < 3; ++br) {
      f32x4 acc[4][4]; zero_acc<4>(acc);
      if (br == 0) gemm_core<true, 4>(ya + (size_t)m0 * 1024, 1024, wl + PA_T + (size_t)n0 * 1024, 1024, 1024, acc, smem);
      else if (br == 1) gemm_core<true, 4>(yb + (size_t)m0 * 512, 512, wl + PB_T + (size_t)n0 * 512, 512, 512, acc, smem);
      else gemm_core<true, 4>(yc + (size_t)m0 * 512, 512, wl + PC_T + (size_t)n0 * 512, 512, 512, acc, smem);
      const int gcol = (br == 0) ? C_GA : (br == 1 ? C_GB : C_GC);
#pragma unroll
      for (int i = 0; i < 4; ++i)
#pragma unroll
        for (int jp = 0; jp < 4; jp += 2) {
          const size_t m = m0 + wm * 64 + i * 16 + (lane & 15);
          uint2 gq[2];
          load16_pair(proj + m * PS + gcol + n0 + wn * 64 + jp * 16, gq[0], gq[1], lane >> 4);
#pragma unroll
          for (int q = 0; q < 2; ++q) {
            const int j = jp + q; const uint2 gg = gq[q];
            mg[i][j][0] += sigmoidf_(bf2f((bf16_t)(gg.x & 0xffff))) * acc[i][j][0];
            mg[i][j][1] += sigmoidf_(bf2f((bf16_t)(gg.x >> 16))) * acc[i][j][1];
            mg[i][j][2] += sigmoidf_(bf2f((bf16_t)(gg.y & 0xffff))) * acc[i][j][2];
            mg[i][j][3] += sigmoidf_(bf2f((bf16_t)(gg.y >> 16))) * acc[i][j][3];
          }
        }
    }
#pragma unroll
    for (int i = 0; i < 4; ++i)
#pragma unroll
      for (int j = 0; j < 4; j += 2) {
        const size_t m = m0 + wm * 64 + i * 16 + (lane & 15);
        uint2 oa, ob;
        oa.x = pack2(mg[i][j][0], mg[i][j][1]); oa.y = pack2(mg[i][j][2], mg[i][j][3]);
        ob.x = pack2(mg[i][j + 1][0], mg[i][j + 1][1]); ob.y = pack2(mg[i][j + 1][2], mg[i][j + 1][3]);
        store16_pair(merged + m * 1024 + n0 + wn * 64 + j * 16, oa, ob, lane >> 4);
      }
  }
}

DI void phase_out(const Params& p, int layer, int half, unsigned char* smem) {
  const bf16_t* wl = (const bf16_t*)(ws_op(p) + OFF_WT) + (size_t)layer * LAYER_W;
  const bf16_t* merged = (const bf16_t*)(ws_op(p) + OFF_H);
  const float* xin = (layer == 0 ? p.in[0] : p.out) + (size_t)half * TH * DM;
  float* xout = p.out + (size_t)half * TH * DM;
  const int tid_ = tid_op(), lane = tid_ & 63, wave = tid_ >> 6, wm = wave >> 1, wn = wave & 1;
  for (int t = (int)blockIdx.x; t < 64 * 8; t += gridDim.x) {
    const int m0 = (t >> 3) * 256, n0 = (t & 7) * 128;
    f32x4 acc[8][4]; zero_acc8(acc);
    gemm_core256<true>(merged + (size_t)m0 * 1024, 1024, wl + WO_T + (size_t)n0 * 1024, 1024, 1024, acc, smem);
#pragma unroll
    for (int i = 0; i < 8; ++i)
#pragma unroll
      for (int j = 0; j < 4; ++j) {
        const size_t m = m0 + wm * 128 + i * 16 + (lane & 15); const int n = n0 + wn * 64 + j * 16 + (lane >> 4) * 4;
        const float4 xv = *(const float4*)(xin + m * DM + n);
        float4 ov; ov.x = xv.x + acc[i][j][0]; ov.y = xv.y + acc[i][j][1]; ov.z = xv.z + acc[i][j][2]; ov.w = xv.w + acc[i][j][3];
        *(float4*)(xout + m * DM + n) = ov;
      }
  }
}

#define XB_TMO      128
#define XB_XCNT(j)  (256  + 64 * (j))
#define XB_XSUB(j)  (1280 + 64 * (j))
#define XB_XGEN(j)  (2304 + 64 * (j))
#define XB_TOP      3328
#define XB_TOPGEN   3392
#define XCD_BAR_WORDS 3456
#define XB_SPIN_CAP (1u << 18)
DI unsigned xb_ld(unsigned* p) { return __hip_atomic_load(p, __ATOMIC_RELAXED, __HIP_MEMORY_SCOPE_AGENT); }
DI unsigned xb_add(unsigned* p, unsigned v) { return __hip_atomic_fetch_add(p, v, __ATOMIC_RELAXED, __HIP_MEMORY_SCOPE_AGENT); }
DI unsigned xb_xcc_id() { return (unsigned)__builtin_amdgcn_s_getreg((3 << 11) | 20) & 0xFu; }
#define XB_SPIN(cond, bar) do { unsigned _sp = 0; while (cond) { __builtin_amdgcn_s_sleep(1); \
    if ((++_sp & 255u) == 0u) { if (xb_ld(&(bar)[XB_TMO])) break; if (_sp > XB_SPIN_CAP) { atomicAdd(&(bar)[XB_TMO], 1u); break; } } } } while (0)
struct XcdBarrier { unsigned* bar; unsigned x; volatile unsigned* st; };
DI XcdBarrier xcd_barrier_post(unsigned* bar, volatile unsigned* st) {
  XcdBarrier b; b.bar = bar; b.x = xb_xcc_id(); b.st = st;
  if (threadIdx.x == 0) (void)xb_add(&bar[XB_XCNT(b.x)], 1u);
  return b;
}
DI void xcd_barrier_complete(unsigned* bar, unsigned x, unsigned& nloc, unsigned& nx) {
  const unsigned G = gridDim.x;
  unsigned sum, cnt, mine, sp = 0u;
  for (;;) {
    sum = 0u; cnt = 0u; mine = 0u;
#pragma unroll
    for (unsigned j = 0; j < 16; ++j) { const unsigned c = xb_ld(&bar[XB_XCNT(j)]); sum += c; cnt += (c > 0u) ? 1u : 0u; mine = (j == x) ? c : mine; }
    if (sum == G) break;
    __builtin_amdgcn_s_sleep(1);
    if ((++sp & 255u) == 0u) { if (xb_ld(&bar[XB_TMO])) break; if (sp > XB_SPIN_CAP) { atomicAdd(&bar[XB_TMO], 1u); break; } }
  }
  nloc = mine > 0u ? mine : 1u; nx = cnt > 0u ? cnt : 1u;
}
DI void xcd_barrier(const XcdBarrier& b_unused, const Params& p, unsigned char* smem) {
  XcdBarrier b; b.x = xb_xcc_id(); b.st = (volatile unsigned*)(smem + 65552); b.bar = nullptr;
  asm volatile("s_waitcnt vmcnt(0)" ::: "memory");
  __syncthreads();
  if (threadIdx.x == 0) {
    unsigned* bar = (unsigned*)(ws_op(p) + OFF_BAR);
    __builtin_amdgcn_s_waitcnt(0);
    unsigned nloc = b.st[0], nx = b.st[1];
    if (nloc == 0u) { xcd_barrier_complete(bar, b.x, nloc, nx); b.st[0] = nloc; b.st[1] = nx; }
    const unsigned old = xb_add(&bar[XB_XSUB(b.x)], 1u);
    const unsigned gen = old / nloc;
    if (old + 1u == (gen + 1u) * nloc) {
      __builtin_amdgcn_fence(__ATOMIC_RELEASE, "agent");
      asm volatile("s_waitcnt vmcnt(0)" ::: "memory");
      const unsigned og = xb_add(&bar[XB_TOP], 1u);
      const unsigned tg = og / nx;
      if (og + 1u == (tg + 1u) * nx) xb_add(&bar[XB_TOPGEN], 1u);
      else XB_SPIN(xb_ld(&bar[XB_TOPGEN]) == tg, bar);
      __builtin_amdgcn_fence(__ATOMIC_ACQUIRE, "agent");
      xb_add(&bar[XB_XGEN(b.x)], 1u);
      asm volatile("s_waitcnt vmcnt(0)" ::: "memory");
    } else {
      XB_SPIN(xb_ld(&bar[XB_XGEN(b.x)]) == gen, bar);
      __builtin_amdgcn_fence(__ATOMIC_ACQUIRE, "agent");
      asm volatile("s_waitcnt vmcnt(0)" ::: "memory");
    }
  }
  __syncthreads();
}

__global__ void __launch_bounds__(256, 2) fwd_megakernel(Params p) {
  cg::grid_group grid = cg::this_grid();
  extern __shared__ __attribute__((aligned(1024))) unsigned char smem[];
  volatile unsigned* xst = (volatile unsigned*)(smem + 65552);
  if (threadIdx.x == 0) { xst[0] = 0u; xst[1] = 0u; }
  __syncthreads();
  const XcdBarrier xb = xcd_barrier_post((unsigned*)(ws_op(p) + OFF_BAR), xst);
  phase_prologue(p, smem);
  phase_norm(p, 0, 0);
  if (p.use_cg_sync) grid.sync();
  xcd_barrier(xb, p, smem);
  for (int layer = 0; layer < 2; ++layer)
    for (int half = 0; half < 2; ++half) {
      if (layer | half) { phase_norm(p, layer, half); xcd_barrier(xb, p, smem); }
      phase_inproj(p, layer, smem);
      xcd_barrier(xb, p, smem);
      phase_mixers(p, layer, half, smem);
      xcd_barrier(xb, p, smem);
      phase_glu(p, layer, smem);
      ret_finalize(p, layer);
      xcd_barrier(xb, p, smem);
      phase_merge(p, layer, smem);
      xcd_barrier(xb, p, smem);
      phase_out(p, layer, half, smem);
      xcd_barrier(xb, p, smem);
    }
}

extern "C" void kernel_launch(void* const* d_in, const int* in_sizes, int n_in, void* d_out, int out_size, void* d_ws, size_t ws_size, hipStream_t stream) {
  static int grid_blocks = 0;
  if (grid_blocks == 0) {
    if (n_in != 22 || ws_size < WS_END) { fprintf(stderr, "kernel_launch: unexpected n_in %d or ws_size %zu (need %zu)\n", n_in, ws_size, (size_t)WS_END); grid_blocks = -1; return; }
    int dev = 0, cus = 0, per_cu = 0;
    hipGetDevice(&dev);
    hipDeviceGetAttribute(&cus, hipDeviceAttributeMultiprocessorCount, dev);
    if (hipFuncSetAttribute((const void*)fwd_megakernel, hipFuncAttributeMaxDynamicSharedMemorySize, SMEM_BYTES) != hipSuccess) { fprintf(stderr, "kernel_launch: hipFuncSetAttribute failed\n"); grid_blocks = -1; return; }
    hipOccupancyMaxActiveBlocksPerMultiprocessor(&per_cu, fwd_megakernel, 256, SMEM_BYTES);
    if (per_cu > 2) per_cu = 2;
    if (per_cu < 1) per_cu = 1;
    grid_blocks = cus * per_cu;
  }
  if (grid_blocks < 0) return;
  Params p{};
  for (int i = 0; i < 22; ++i) p.in[i] = (const float*)d_in[i];
  p.out = (float*)d_out; p.ws = (unsigned char*)d_ws; p.use_cg_sync = 0; p.pad_ = 0;
  if (hipMemsetAsync((unsigned char*)d_ws + OFF_CTR, 0, 256 + 3456 * 4, stream) != hipSuccess) { fprintf(stderr, "kernel_launch: memset of control words failed\n"); return; }
  void* args[] = {&p};
  hipError_t e = hipLaunchCooperativeKernel((void*)fwd_megakernel, dim3(grid_blocks), dim3(256), args, SMEM_BYTES, stream);
  if (e != hipSuccess) fprintf(stderr, "cooperative launch failed: %s (grid %d)\n", hipGetErrorString(e), grid_blocks);
}
```

```cpp
#include <hip/hip_runtime.h>
#include <hip/hip_cooperative_groups.h>
#include <cstdio>
#include <cstdint>
namespace cg = cooperative_groups;

typedef unsigned short bf16_t;
typedef short bf16x8 __attribute__((ext_vector_type(8)));
typedef short s16x4 __attribute__((ext_vector_type(4)));
typedef float f32x4 __attribute__((ext_vector_type(4)));
typedef float f32x16 __attribute__((ext_vector_type(16)));
typedef unsigned u32x4 __attribute__((ext_vector_type(4)));
#define DI __device__ __forceinline__
#define MFMA16(a, b, c) __builtin_amdgcn_mfma_f32_16x16x32_bf16((a), (b), (c), 0, 0, 0)
#define MFMA32(a, b, c) __builtin_amdgcn_mfma_f32_32x32x16_bf16((a), (b), (c), 0, 0, 0)

constexpr int DM = 1024, SEQ = 2048, HB = 8, TH = HB * SEQ  , PS = 7680  ;
constexpr float EPS = 1e-6f;
constexpr int C_RQ = 0, C_RK = 512, C_RZ = 1024, C_SQ = 2048, C_SK = 2560, C_SZ = 3072, C_CU = 3584, C_CZ = 4096, C_GA = 4608, C_GB = 5632, C_GC = 6656;
constexpr size_t W_IN_T = 0, W_GLU_T = 9437184, PA_T = 9699328, PB_T = 10747904, PC_T = 11272192, WO_T = 11796480, LAYER_W = 12845056;
constexpr size_t OFF_WT = 0;
constexpr size_t OFF_ROPE = 2 * LAYER_W * 2;
constexpr size_t OFF_H = OFF_ROPE + 2 * 2048 * 64 * 4;
constexpr size_t OFF_PROJ = OFF_H + (size_t)TH * 1024 * 2;
constexpr size_t OFF_RVT = OFF_PROJ + (size_t)TH * PS * 2;
constexpr size_t OFF_SVT = OFF_RVT + (size_t)8 * 4 * 256 * 2048 * 2;
constexpr size_t OFF_YA = OFF_SVT + (size_t)8 * 8 * 64 * 2048 * 2;
constexpr size_t OFF_YB = OFF_YA + (size_t)TH * 1024 * 2;
constexpr size_t OFF_YCP = OFF_YB + (size_t)TH * 512 * 2;
constexpr size_t OFF_YC = OFF_YCP + (size_t)TH * 512 * 2;
constexpr size_t OFF_KDT = OFF_YC + (size_t)TH * 512 * 2;
constexpr size_t OFF_SSQ = OFF_KDT + (size_t)8 * 4 * 128 * 2048 * 2;
constexpr size_t SSMT_KT = 0, SSMT_P = 16896, SSMT_Q = 16896 + 131072, SSMT_A32 = 16896 + 2 * 131072, SSMT_STRIDE = 16896 + 2 * 131072 + 512;
constexpr size_t OFF_SSMT = OFF_SSQ + (size_t)TH * 16 * 4;
constexpr size_t OFF_CTR = OFF_SSMT + 64 * SSMT_STRIDE;
constexpr size_t OFF_BAR = OFF_CTR + 256;
constexpr size_t WS_END = OFF_BAR + 3456 * 4;
static_assert(WS_END <= 536870912, "workspace map exceeds 4x the largest tensor");

constexpr int SMEM_BYTES = 67584;

struct Params { const float* in[22]; float* out; unsigned char* ws; int use_cg_sync; int pad_; };

DI unsigned char* ws_op(const Params& p) { size_t z = 0; asm volatile("" : "+s"(z)); return p.ws + z; }
DI float shx(float v, int k, int lane) { return __builtin_bit_cast(float, __builtin_amdgcn_ds_bpermute((lane ^ k) << 2, __builtin_bit_cast(int, v))); }
DI float bf2f(bf16_t v) { return __uint_as_float(((unsigned)v) << 16); }
DI bf16_t f2bf(float x) { unsigned u = __float_as_uint(x); u += 0x7fffu + ((u >> 16) & 1u); return (bf16_t)(u >> 16); }
DI unsigned pack2(float lo, float hi) { unsigned r; asm volatile("v_cvt_pk_bf16_f32 %0, %1, %2" : "=v"(r) : "v"(lo), "v"(hi)); return r; }
DI float sigmoidf_(float x) { return __builtin_amdgcn_rcpf(1.0f + __expf(-x)); }
DI float siluf_(float x) { return x * sigmoidf_(x); }
DI float gelu_tanh(float y) { float a = 0.7978845608028654f * (y + 0.044715f * y * y * y); float t = 1.0f - 2.0f * __builtin_amdgcn_rcpf(__expf(2.0f * a) + 1.0f); return 0.5f * y * (1.0f + t); }
DI void swap16(unsigned& a, unsigned& b) { asm volatile("v_nop\n\tv_nop\n\tv_permlane16_swap_b32 %0, %1" : "+v"(a), "+v"(b)); }
DI void store16_pair(bf16_t* rowp, uint2 a, uint2 b, int kq, int odd_off = 16) {
  swap16(a.x, b.x); swap16(a.y, b.y);
  *(u32x4*)(rowp + (kq & 1) * odd_off + (kq >> 1) * 8) = u32x4{a.x, a.y, b.x, b.y};
}
DI void load16_pair(const bf16_t* rowp, uint2& a, uint2& b, int kq, int odd_off = 16) {
  const u32x4 v = *(const u32x4*)(rowp + (kq & 1) * odd_off + (kq >> 1) * 8);
  a.x = v[0]; a.y = v[1]; b.x = v[2]; b.y = v[3];
  swap16(a.x, b.x); swap16(a.y, b.y);
}
DI void swap32(unsigned& a, unsigned& b) { asm volatile("v_nop\n\tv_nop\n\tv_permlane32_swap_b32 %0, %1" : "+v"(a), "+v"(b)); }
DI void store32_pair(bf16_t* p8  , uint2 a, uint2 b, int h2) {
  swap32(a.x, b.x); swap32(a.y, b.y);
  *(u32x4*)(p8 + h2 * 8) = u32x4{a.x, a.y, b.x, b.y};
}
DI void load32_pair(const bf16_t* p8, uint2& a, uint2& b, int h2) {
  const u32x4 v = *(const u32x4*)(p8 + h2 * 8);
  a.x = v[0]; a.y = v[1]; b.x = v[2]; b.y = v[3];
  swap32(a.x, b.x); swap32(a.y, b.y);
}
DI int crow(int reg, int h2) { return (reg & 3) + 8 * (reg >> 2) + 4 * h2; }
DI int tid_op() { int t = threadIdx.x; asm volatile("" : "+v"(t)); return t; }
struct Params;
DI unsigned char* ws_op(const Params& p);

constexpr int BK = 64;
DI int lds_byte2(int r, int c) { const int st = (r >> 4) * 2 + (c >> 5), ob = (r & 15) * 64 + (c & 31) * 2; return st * 1024 + (ob ^ (((ob >> 9) & 1) << 5)); }
DI void stage_rc2(int b, int& R, int& C) { const int st = b >> 10, sb = b & 1023, swz = sb ^ (((sb >> 9) & 1) << 5); R = (st >> 1) * 16 + (swz >> 6); C = (st & 1) * 32 + ((swz & 63) >> 1); }
#define WAIT_VM0() asm volatile("s_waitcnt vmcnt(0)" ::: "memory")
template <bool SWAP, int NJ>
DI void gemm_core(const bf16_t* __restrict__ A, int lda, const bf16_t* __restrict__ Bt, int ldb, int K, f32x4 (&acc)[4][NJ], unsigned char* sm, bool pre = false) {
  const int tid = tid_op(), lane = tid & 63, wid = tid >> 6, wm = wid >> 1, wn = wid & 1, fr = lane & 15, fq = lane >> 4;
  int aoff[4], boff[NJ];
#pragma unroll
  for (int i = 0; i < 4; ++i) { int R, C; stage_rc2(wid * 1024 + i * 4096 + lane * 16, R, C); aoff[i] = R * lda + C; }
#pragma unroll
  for (int i = 0; i < NJ; ++i) { int R, C; stage_rc2(wid * 1024 + i * 4096 + lane * 16, R, C); boff[i] = R * ldb + C; }
  const int lo = (fr * 64 + fq * 16) ^ ((fr >> 3) << 5);
  const int nt = K / BK;
  if (!pre) {
    __syncthreads();
#pragma unroll
    for (int i = 0; i < 4; ++i) __builtin_amdgcn_global_load_lds((const unsigned*)(A + aoff[i]), (__attribute__((address_space(3))) unsigned*)(sm + wid * 1024 + i * 4096), 16, 0, 0);
#pragma unroll
    for (int i = 0; i < NJ; ++i) __builtin_amdgcn_global_load_lds((const unsigned*)(Bt + boff[i]), (__attribute__((address_space(3))) unsigned*)(sm + 16384 + wid * 1024 + i * 4096), 16, 0, 0);
  }
  WAIT_VM0();
  __syncthreads();
  for (int t = 0; t < nt; ++t) {
    unsigned char* cur = sm + (t & 1) * 32768;
    unsigned char* nxt = sm + ((t & 1) ^ 1) * 32768;
    if (t + 1 < nt) {
      const int ko = (t + 1) * BK;
#pragma unroll
      for (int i = 0; i < 4; ++i) __builtin_amdgcn_global_load_lds((const unsigned*)(A + aoff[i] + ko), (__attribute__((address_space(3))) unsigned*)(nxt + wid * 1024 + i * 4096), 16, 0, 0);
#pragma unroll
      for (int i = 0; i < NJ; ++i) __builtin_amdgcn_global_load_lds((const unsigned*)(Bt + boff[i] + ko), (__attribute__((address_space(3))) unsigned*)(nxt + 16384 + wid * 1024 + i * 4096), 16, 0, 0);
    }
    bf16x8 af[2][4], bfr[2][NJ];
#pragma unroll
    for (int ks = 0; ks < 2; ++ks) {
#pragma unroll
      for (int i = 0; i < 4; ++i) af[ks][i] = *(const bf16x8*)(cur + ((wm * 4 + i) * 2 + ks) * 1024 + lo);
#pragma unroll
      for (int j = 0; j < NJ; ++j) bfr[ks][j] = *(const bf16x8*)(cur + 16384 + ((wn * NJ + j) * 2 + ks) * 1024 + lo);
      __builtin_amdgcn_sched_barrier(0);
    }
#pragma unroll
    for (int ks = 0; ks < 2; ++ks) {
#pragma unroll
      for (int i = 0; i < 4; ++i)
#pragma unroll
        for (int j = 0; j < NJ; ++j) acc[i][j] = SWAP ? MFMA16(bfr[ks][j], af[ks][i], acc[i][j]) : MFMA16(af[ks][i], bfr[ks][j], acc[i][j]);
      __builtin_amdgcn_sched_barrier(0);
    }
    WAIT_VM0();
    __syncthreads();
  }
}

DI void gemm_issue0(const bf16_t* __restrict__ A, int lda, const bf16_t* __restrict__ Bt, int ldb, unsigned char* sm) {
  const int tid = tid_op(), lane = tid & 63, wid = tid >> 6;
#pragma unroll
  for (int i = 0; i < 4; ++i) {
    int R, C; stage_rc2(wid * 1024 + i * 4096 + lane * 16, R, C);
    __builtin_amdgcn_global_load_lds((const unsigned*)(A + R * lda + C), (__attribute__((address_space(3))) unsigned*)(sm + wid * 1024 + i * 4096), 16, 0, 0);
    __builtin_amdgcn_global_load_lds((const unsigned*)(Bt + R * ldb + C), (__attribute__((address_space(3))) unsigned*)(sm + 16384 + wid * 1024 + i * 4096), 16, 0, 0);
  }
}
template <bool SWAP>
DI void gemm_core256(const bf16_t* __restrict__ A, int lda, const bf16_t* __restrict__ Bt, int ldb, int K, f32x4 (&acc)[8][4], unsigned char* sm) {
  const int tid = tid_op(), lane = tid & 63, wid = tid >> 6, wm = wid >> 1, wn = wid & 1, fr = lane & 15, fq = lane >> 4;
  int aoff[4], boff[2];
#pragma unroll
  for (int i = 0; i < 4; ++i) { const int b = wid * 1024 + i * 4096 + lane * 16, R = b >> 6, c = ((b >> 4) & 3) ^ ((-(R >> 2)) & 3); aoff[i] = R * lda + c * 8; }
#pragma unroll
  for (int i = 0; i < 2; ++i) { const int b = wid * 1024 + i * 4096 + lane * 16, R = b >> 6, c = ((b >> 4) & 3) ^ ((-(R >> 2)) & 3); boff[i] = R * ldb + c * 8; }
  const int lo = fr * 64 + ((fq ^ ((-(fr >> 2)) & 3)) << 4);
  const int nt = K / 32;
  __syncthreads();
#pragma unroll
  for (int i = 0; i < 4; ++i) __builtin_amdgcn_global_load_lds((const unsigned*)(A + aoff[i]), (__attribute__((address_space(3))) unsigned*)(sm + wid * 1024 + i * 4096), 16, 0, 0);
#pragma unroll
  for (int i = 0; i < 2; ++i) __builtin_amdgcn_global_load_lds((const unsigned*)(Bt + boff[i]), (__attribute__((address_space(3))) unsigned*)(sm + 16384 + wid * 1024 + i * 4096), 16, 0, 0);
  WAIT_VM0();
  __syncthreads();
  for (int t = 0; t < nt; ++t) {
    unsigned char* cur = sm + (t & 1) * 24576;
    unsigned char* nxt = sm + ((t & 1) ^ 1) * 24576;
    if (t + 1 < nt) {
      const int ko = (t + 1) * 32;
#pragma unroll
      for (int i = 0; i < 4; ++i) __builtin_amdgcn_global_load_lds((const unsigned*)(A + aoff[i] + ko), (__attribute__((address_space(3))) unsigned*)(nxt + wid * 1024 + i * 4096), 16, 0, 0);
#pragma unroll
      for (int i = 0; i < 2; ++i) __builtin_amdgcn_global_load_lds((const unsigned*)(Bt + boff[i] + ko), (__attribute__((address_space(3))) unsigned*)(nxt + 16384 + wid * 1024 + i * 4096), 16, 0, 0);
    }
    bf16x8 af[8], bfr[4];
#pragma unroll
    for (int i = 0; i < 8; ++i) af[i] = *(const bf16x8*)(cur + (wm * 8 + i) * 1024 + lo);
#pragma unroll
    for (int j = 0; j < 4; ++j) bfr[j] = *(const bf16x8*)(cur + 16384 + (wn * 4 + j) * 1024 + lo);
    __builtin_amdgcn_sched_barrier(0);
#pragma unroll
    for (int i = 0; i < 8; ++i)
#pragma unroll
      for (int j = 0; j < 4; ++j) acc[i][j] = SWAP ? MFMA16(bfr[j], af[i], acc[i][j]) : MFMA16(af[i], bfr[j], acc[i][j]);
    __builtin_amdgcn_sched_barrier(0);
    WAIT_VM0();
    __syncthreads();
  }
}
DI void zero_acc8(f32x4 (&acc)[8][4]) {
#pragma unroll
  for (int i = 0; i < 8; ++i)
#pragma unroll
    for (int j = 0; j < 4; ++j) acc[i][j] = f32x4{0.f, 0.f, 0.f, 0.f};
}
template <int NJ>
DI void zero_acc(f32x4 (&acc)[4][NJ]) {
#pragma unroll
  for (int i = 0; i < 4; ++i)
#pragma unroll
    for (int j = 0; j < NJ; ++j) acc[i][j] = f32x4{0.f, 0.f, 0.f, 0.f};
}

DI void transpose_tile(const float* __restrict__ W, int K, int N, bf16_t* __restrict__ WT, int tile, float* sm) {
  const int tid = tid_op();
  const int ntn = N >> 6, kt = tile / ntn, nt = tile % ntn;
  __syncthreads();
#pragma unroll
  for (int i = 0; i < 4; ++i) {
    int idx = tid + i * 256, row = idx >> 4, c4 = (idx & 15) * 4;
    float4 v = *(const float4*)(W + (size_t)(kt * 64 + row) * N + nt * 64 + c4);
    sm[row * 65 + c4 + 0] = v.x; sm[row * 65 + c4 + 1] = v.y; sm[row * 65 + c4 + 2] = v.z; sm[row * 65 + c4 + 3] = v.w;
  }
  __syncthreads();
  const int n = tid >> 2, kq = (tid & 3) * 16;
  unsigned pk[8];
#pragma unroll
  for (int i = 0; i < 8; ++i) pk[i] = pack2(sm[(kq + 2 * i) * 65 + n], sm[(kq + 2 * i + 1) * 65 + n]);
  uint4* dst = (uint4*)(WT + (size_t)(nt * 64 + n) * K + kt * 64 + kq);
  dst[0] = uint4{pk[0], pk[1], pk[2], pk[3]};
  dst[1] = uint4{pk[4], pk[5], pk[6], pk[7]};
}

DI void ssm_tables(const Params& p, int layer, int g, float* sm, int part, int nparts) {
  float* pwr = sm; float* pwi = pwr + 33 * 64; float* bbr = pwi + 33 * 64; float* bbi = bbr + 1024; float* cr = bbi + 1024; float* ci = cr + 1024;
  const int tid = tid_op(), gi = layer * 32 + g;
  unsigned char* tb = ws_op(p) + OFF_SSMT + (size_t)gi * SSMT_STRIDE;
  __syncthreads();
  if (tid < 64) {
    const float a_re = p.in[8][gi * 64 + tid], a_im = p.in[9][gi * 64 + tid];
    const float dt = expf(p.in[10][gi]);
    const float mag = expf(dt * a_re);
    const float abr = mag * cosf(dt * a_im), abi = mag * sinf(dt * a_im);
    const float den = a_re * a_re + a_im * a_im, nr = abr - 1.0f;
    const float cfr = (nr * a_re + abi * a_im) / den, cfi = (abi * a_re - nr * a_im) / den;
    const float* bre = p.in[11] + ((size_t)gi * 64 + tid) * 16;
    const float* bim = p.in[12] + ((size_t)gi * 64 + tid) * 16;
    for (int m = 0; m < 16; ++m) { const float br = bre[m], bi = bim[m]; bbr[tid * 16 + m] = cfr * br - cfi * bi; bbi[tid * 16 + m] = cfr * bi + cfi * br; }
    float pr = 1.0f, pi = 0.0f;
    for (int t = 0; t <= 32; ++t) { pwr[t * 64 + tid] = pr; pwi[t * 64 + tid] = pi; const float nr2 = pr * abr - pi * abi, ni2 = pr * abi + pi * abr; pr = nr2; pi = ni2; }
    float* a32 = (float*)(tb + SSMT_A32);
    if (part == 0) { a32[tid] = pwr[32 * 64 + tid]; a32[64 + tid] = pwi[32 * 64 + tid]; }
  }
  for (int idx = tid; idx < 1024; idx += 256) { cr[idx] = p.in[13][(size_t)gi * 1024 + idx]; ci[idx] = p.in[14][(size_t)gi * 1024 + idx]; }
  __syncthreads();
  bf16_t* KT = (bf16_t*)(tb + SSMT_KT); bf16_t* P = (bf16_t*)(tb + SSMT_P); bf16_t* Q = (bf16_t*)(tb + SSMT_Q);
  for (int idx = tid + part * 256; idx < 33 * 256; idx += 256 * nparts) {
    const int t1 = idx >> 8, m = (idx >> 4) & 15, mp = idx & 15;
    float acc = 0.f;
    if (t1 > 0) {
      const int t = t1 - 1;
      for (int q = 0; q < 64; ++q) {
        const float ar = pwr[t * 64 + q], ai = pwi[t * 64 + q], br = bbr[q * 16 + mp], bi = bbi[q * 16 + mp];
        acc += cr[m * 64 + q] * (ar * br - ai * bi) - ci[m * 64 + q] * (ar * bi + ai * br);
      }
    }
    KT[idx] = f2bf(acc);
  }
  for (int idx = tid + part * 256; idx < 128 * 512; idx += 256 * nparts) {
    const int pp = idx >> 9, k = idx & 511, j = k >> 4, mp = k & 15, q = pp & 63, e = 31 - j;
    const float ar = pwr[e * 64 + q], ai = pwi[e * 64 + q], br = bbr[q * 16 + mp], bi = bbi[q * 16 + mp];
    P[idx] = f2bf(pp < 64 ? (ar * br - ai * bi) : (ar * bi + ai * br));
  }
  for (int idx = tid + part * 256; idx < 512 * 128; idx += 256 * nparts) {
    const int row = idx >> 7, pp = idx & 127, i = row >> 4, m = row & 15, q = pp & 63;
    const float ar = pwr[(i + 1) * 64 + q], ai = pwi[(i + 1) * 64 + q], c_r = cr[m * 64 + q], c_i = ci[m * 64 + q];
    Q[idx] = f2bf(pp < 64 ? (c_r * ar - c_i * ai) : (-c_r * ai - c_i * ar));
  }
}

struct TrTask { const float* W; bf16_t* WT; int K, N, tile; };
DI TrTask tr_resolve(const Params& p, int u) {
  const int layer = u / 3136, r = u % 3136;
  bf16_t* wl = (bf16_t*)(ws_op(p) + OFF_WT) + (size_t)layer * LAYER_W;
  TrTask t;
  if (r < 2304) { t.W = p.in[2] + (size_t)layer * 1024 * 9216; t.K = 1024; t.N = 9216; t.WT = wl + W_IN_T; t.tile = r; }
  else if (r < 2368) { t.W = p.in[16] + (size_t)layer * 512 * 512; t.K = 512; t.N = 512; t.WT = wl + W_GLU_T; t.tile = r - 2304; }
  else if (r < 2624) { t.W = p.in[18] + (size_t)layer * 1024 * 1024; t.K = 1024; t.N = 1024; t.WT = wl + PA_T; t.tile = r - 2368; }
  else if (r < 2752) { t.W = p.in[19] + (size_t)layer * 512 * 1024; t.K = 512; t.N = 1024; t.WT = wl + PB_T; t.tile = r - 2624; }
  else if (r < 2880) { t.W = p.in[20] + (size_t)layer * 512 * 1024; t.K = 512; t.N = 1024; t.WT = wl + PC_T; t.tile = r - 2752; }
  else { t.W = p.in[21] + (size_t)layer * 1024 * 1024; t.K = 1024; t.N = 1024; t.WT = wl + WO_T; t.tile = r - 2880; }
  return t;
}
DI void tr_load(const TrTask& t, int tid, f32x4 (&v)[4]) {
  const int ntn = t.N >> 6, kt = t.tile / ntn, nt = t.tile % ntn;
#pragma unroll
  for (int i = 0; i < 4; ++i) { const int idx = tid + i * 256, row = idx >> 4, c4 = (idx & 15) * 4; v[i] = *(const f32x4*)(t.W + (size_t)(kt * 64 + row) * t.N + nt * 64 + c4); }
}
DI void tr_finish(const TrTask& t, int tid, const f32x4 (&v)[4], float* sm) {
  const int ntn = t.N >> 6, kt = t.tile / ntn, nt = t.tile % ntn;
  __syncthreads();
#pragma unroll
  for (int i = 0; i < 4; ++i) { const int idx = tid + i * 256, row = idx >> 4, c4 = (idx & 15) * 4; sm[row * 65 + c4 + 0] = v[i][0]; sm[row * 65 + c4 + 1] = v[i][1]; sm[row * 65 + c4 + 2] = v[i][2]; sm[row * 65 + c4 + 3] = v[i][3]; }
  __syncthreads();
  const int n = tid >> 2, kq = (tid & 3) * 16;
  u32x4 lo, hi;
#pragma unroll
  for (int i = 0; i < 4; ++i) { lo[i] = pack2(sm[(kq + 2 * i) * 65 + n], sm[(kq + 2 * i + 1) * 65 + n]); hi[i] = pack2(sm[(kq + 8 + 2 * i) * 65 + n], sm[(kq + 9 + 2 * i) * 65 + n]); }
  u32x4* dst = (u32x4*)(t.WT + (size_t)(nt * 64 + n) * t.K + kt * 64 + kq);
  dst[0] = lo; dst[1] = hi;
}

DI void phase_prologue(const Params& p, unsigned char* smem) {
  float* sm = (float*)smem;
  const int tid = tid_op();
  const int G = (int)gridDim.x, bid = (int)blockIdx.x;
  for (int q = bid; q < 256; q += G) ssm_tables(p, q >> 7, (q >> 2) & 31, sm, q & 3, 4);
  {
    int u = bid;
    f32x4 cur[4], nxt[4];
    if (u < 2 * 3136) { const TrTask t0 = tr_resolve(p, u); tr_load(t0, tid, cur); }
    for (; u < 2 * 3136; u += G) {
      const int un = u + G;
      if (un < 2 * 3136) { const TrTask tn = tr_resolve(p, un); tr_load(tn, tid, nxt); }
      const TrTask t = tr_resolve(p, u);
      tr_finish(t, tid, cur, sm);
#pragma unroll
      for (int i = 0; i < 4; ++i) cur[i] = nxt[i];
    }
  }
  for (int r = bid; r < 512; r += G) {
    const int idx = r * 256 + tid;
    const int pos = idx >> 6, i = idx & 63;
    const float inv = exp2f(-(float)i * (13.287712379549449f / 64.0f));
    const float ang = (float)pos * inv;
    float* cosT = (float*)(ws_op(p) + OFF_ROPE); float* sinT = cosT + 2048 * 64;
    cosT[idx] = cosf(ang); sinT[idx] = sinf(ang);
  }
}

DI void phase_norm(const Params& p, int layer, int half) {
  const float* xin = (layer == 0 ? p.in[0] : p.out) + (size_t)half * TH * DM;
  const float* g = p.in[1] + layer * DM;
  bf16_t* h = (bf16_t*)(ws_op(p) + OFF_H);
  const int tid_ = tid_op(), lane = tid_ & 63, wave = tid_ >> 6;
  for (int row = (int)blockIdx.x * 4 + wave; row < TH; row += gridDim.x * 4) {
    const float* xr = xin + (size_t)row * DM;
    float4 v[4]; float ss = 0.f;
#pragma unroll
    for (int i = 0; i < 4; ++i) { v[i] = *(const float4*)(xr + i * 256 + lane * 4); ss += v[i].x * v[i].x + v[i].y * v[i].y + v[i].z * v[i].z + v[i].w * v[i].w; }
#pragma unroll
    for (int o = 32; o >= 1; o >>= 1) ss += shx(ss, o, lane);
    const float rstd = rsqrtf(ss * (1.0f / 1024.0f) + EPS);
#pragma unroll
    for (int i = 0; i < 4; ++i) {
      float4 g4 = *(const float4*)(g + i * 256 + lane * 4);
      uint2 o2; o2.x = pack2(v[i].x * rstd * g4.x, v[i].y * rstd * g4.y); o2.y = pack2(v[i].z * rstd * g4.z, v[i].w * rstd * g4.w);
      *(uint2*)(h + (size_t)row * DM + i * 256 + lane * 4) = o2;
    }
  }
}

DI void phase_inproj(const Params& p, int layer, unsigned char* smem) {
  const bf16_t* h = (const bf16_t*)(ws_op(p) + OFF_H);
  const bf16_t* WinT = (const bf16_t*)(ws_op(p) + OFF_WT) + (size_t)layer * LAYER_W + W_IN_T;
  bf16_t* proj = (bf16_t*)(ws_op(p) + OFF_PROJ);
  bf16_t* rvt = (bf16_t*)(ws_op(p) + OFF_RVT);
  bf16_t* svt = (bf16_t*)(ws_op(p) + OFF_SVT);
  const int tid_ = tid_op(), lane = tid_ & 63, wave = tid_ >> 6, wm = wave >> 1, wn = wave & 1;
  bool pre = false;
  for (int t = (int)blockIdx.x; t < 128 * 72; t += gridDim.x) {
    const int mt = t / 72, nt = t % 72, m0 = mt * 128, n0 = nt * 128;
    f32x4 acc[4][4]; zero_acc<4>(acc);
    const bool isrv = (n0 >= 1024 && n0 < 2048), issv = (n0 >= 4096 && n0 < 4608);
    const int tn = t + (int)gridDim.x;
    const bool chain = (tn < 128 * 72) && (isrv || issv || n0 >= 1024);
    const bf16_t* An = h + (size_t)((tn / 72) * 128) * DM; const bf16_t* Bn = WinT + (size_t)((tn % 72) * 128) * DM;
    if (isrv || issv) {
      gemm_core<false, 4>(h + (size_t)m0 * DM, DM, WinT + (size_t)n0 * DM, DM, DM, acc, smem, pre);
      pre = chain;
      if (chain) gemm_issue0(An, DM, Bn, DM, smem);
#pragma unroll
      for (int i = 0; i < 4; i += 2)
#pragma unroll
        for (int j = 0; j < 4; ++j) {
          const int mb = m0 + wm * 64 + i * 16, n = n0 + wn * 64 + j * 16 + (lane & 15);
          const int bl = mb >> 11, s = mb & 2047;
          uint2 oa, ob;
          oa.x = pack2(acc[i][j][0], acc[i][j][1]); oa.y = pack2(acc[i][j][2], acc[i][j][3]);
          ob.x = pack2(acc[i + 1][j][0], acc[i + 1][j][1]); ob.y = pack2(acc[i + 1][j][2], acc[i + 1][j][3]);
          bf16_t* rowp;
          if (isrv) { const int c = n - 1024, hh = c >> 8, dv = c & 255; rowp = rvt + ((size_t)((bl * 4 + hh) * 256 + dv)) * 2048 + s; }
          else { const int c = n - 4096, hh = c >> 6, dv = c & 63; rowp = svt + ((size_t)((bl * 8 + hh) * 64 + dv)) * 2048 + s; }
          store16_pair(rowp, oa, ob, lane >> 4);
        }
    } else {
      gemm_core<true, 4>(h + (size_t)m0 * DM, DM, WinT + (size_t)n0 * DM, DM, DM, acc, smem, pre);
      pre = chain;
      if (chain) gemm_issue0(An, DM, Bn, DM, smem);
      const int shift = (n0 >= 2048 ? 1024 : 0) + (n0 >= 4608 ? 512 : 0);
      const int fr = lane & 15, kq = lane >> 4;
      if (n0 >= 3072 && n0 < 4096) {
        const bool isq = n0 < 3584;
        const float* gain = (isq ? p.in[6] : p.in[7]) + layer * 64;
#pragma unroll
        for (int i = 0; i < 4; ++i) {
          float ss = 0.f;
#pragma unroll
          for (int j = 0; j < 4; ++j) ss += acc[i][j][0] * acc[i][j][0] + acc[i][j][1] * acc[i][j][1] + acc[i][j][2] * acc[i][j][2] + acc[i][j][3] * acc[i][j][3];
          ss += shx(ss, 16, lane); ss += shx(ss, 32, lane);
          const float rs = rsqrtf(ss * (1.0f / 64.0f) + EPS) * (isq ? 0.125f : 1.0f);
#pragma unroll
          for (int j = 0; j < 4; ++j) { const float4 g4 = *(const float4*)(gain + j * 16 + kq * 4); acc[i][j][0] *= rs * g4.x; acc[i][j][1] *= rs * g4.y; acc[i][j][2] *= rs * g4.z; acc[i][j][3] *= rs * g4.w; }
        }
      } else if (n0 < 1024) {
        const bool isq = n0 < 512;
        const int hk = (n0 & 511) >> 7;
        const float* gain = (isq ? p.in[3] : p.in[4]) + layer * 128 + wn * 64;
        float* xv = (float*)smem;
        float* ssx = (float*)(smem + 65600);
        const float* cosT = (const float*)(ws_op(p) + OFF_ROPE); const float* sinT = cosT + 2048 * 64;
        float ssp[4];
#pragma unroll
        for (int i = 0; i < 4; ++i) {
          float ss = 0.f;
#pragma unroll
          for (int j = 0; j < 4; ++j) ss += acc[i][j][0] * acc[i][j][0] + acc[i][j][1] * acc[i][j][1] + acc[i][j][2] * acc[i][j][2] + acc[i][j][3] * acc[i][j][3];
          ss += shx(ss, 16, lane); ss += shx(ss, 32, lane);
          ssp[i] = ss;
          if (kq == 0) ssx[wave * 64 + i * 16 + fr] = ss;
        }
        __syncthreads();
#pragma unroll
        for (int i = 0; i < 4; ++i) {
          const float rs = rsqrtf((ssp[i] + ssx[(wave ^ 1) * 64 + i * 16 + fr]) * (1.0f / 128.0f) + EPS);
#pragma unroll
          for (int j = 0; j < 4; ++j) {
            const float4 g4 = *(const float4*)(gain + j * 16 + kq * 4);
            acc[i][j][0] *= rs * g4.x; acc[i][j][1] *= rs * g4.y; acc[i][j][2] *= rs * g4.z; acc[i][j][3] *= rs * g4.w;
#pragma unroll
            for (int r = 0; r < 4; ++r) xv[wave * 4096 + ((i * 4 + j) * 4 + r) * 64 + lane] = acc[i][j][r];
          }
        }
        __syncthreads();
        const float sgn = wn ? 1.0f : -1.0f, ksc = isq ? 1.0f : 0.08838834764831845f;
        const float lg2k = log2f(1.0f - exp2f(-5.0f - (float)hk));
#pragma unroll
        for (int i = 0; i < 4; ++i) {
          const int m = m0 + wm * 64 + i * 16 + fr, pos = m & 2047;
          const float kd = exp2f((float)(127 - (pos & 127)) * lg2k);
          bf16_t* kdst = (bf16_t*)(ws_op(p) + OFF_KDT) + ((size_t)(((m >> 11) * 4 + hk) * 128 + wn * 64)) * 2048 + pos;
#pragma unroll
          for (int j = 0; j < 4; ++j) {
            const float4 c4 = *(const float4*)(cosT + pos * 64 + j * 16 + kq * 4), s4 = *(const float4*)(sinT + pos * 64 + j * 16 + kq * 4);
            const float cc[4] = {c4.x, c4.y, c4.z, c4.w}, sn[4] = {s4.x, s4.y, s4.z, s4.w};
#pragma unroll
            for (int r = 0; r < 4; ++r) {
              const float other = xv[(wave ^ 1) * 4096 + ((i * 4 + j) * 4 + r) * 64 + lane];
              const float o = (acc[i][j][r] * cc[r] + sgn * other * sn[r]) * ksc;
              acc[i][j][r] = o;
              if (!isq) kdst[(size_t)(j * 16 + kq * 4 + r) * 2048] = f2bf(o * kd);
            }
            uint2 o2; o2.x = pack2(acc[i][j][0], acc[i][j][1]); o2.y = pack2(acc[i][j][2], acc[i][j][3]);
            *(uint2*)(proj + (size_t)m * PS + n0 + wn * 64 + j * 16 + kq * 4) = o2;
          }
        }
        continue;
      }
#pragma unroll
      for (int i = 0; i < 4; ++i)
#pragma unroll
        for (int j = 0; j < 4; j += 2) {
          const int m = m0 + wm * 64 + i * 16 + (lane & 15);
          uint2 oa, ob;
          oa.x = pack2(acc[i][j][0], acc[i][j][1]); oa.y = pack2(acc[i][j][2], acc[i][j][3]);
          ob.x = pack2(acc[i][j + 1][0], acc[i][j + 1][1]); ob.y = pack2(acc[i][j + 1][2], acc[i][j + 1][3]);
          store16_pair(proj + (size_t)m * PS + n0 - shift + wn * 64 + j * 16, oa, ob, lane >> 4);
        }
    }
  }
}

DI bf16x8 pack_frag(const f32x16& x, int s) {
  u32x4 p;
  asm volatile("v_cvt_pk_bf16_f32 %0, %4, %5\n\tv_cvt_pk_bf16_f32 %1, %6, %7\n\tv_cvt_pk_bf16_f32 %2, %8, %9\n\tv_cvt_pk_bf16_f32 %3, %10, %11\n\ts_nop 1"
               : "=&v"(p[0]), "=&v"(p[1]), "=&v"(p[2]), "=&v"(p[3])
               : "v"(x[8 * s]), "v"(x[8 * s + 1]), "v"(x[8 * s + 2]), "v"(x[8 * s + 3]), "v"(x[8 * s + 4]), "v"(x[8 * s + 5]), "v"(x[8 * s + 6]), "v"(x[8 * s + 7]));
  return __builtin_bit_cast(bf16x8, p);
}

DI void sb_item(const Params& p, int b, int h, int qi, unsigned char* smem) {
  bf16_t* Ks = (bf16_t*)smem;
  bf16_t* Vt = Ks + 128 * 72;
  const bf16_t* proj = (const bf16_t*)(ws_op(p) + OFF_PROJ);
  const bf16_t* svt = (const bf16_t*)(ws_op(p) + OFF_SVT);
  bf16_t* yb = (bf16_t*)(ws_op(p) + OFF_YB);
  const int tid = tid_op(), lane = tid & 63, wave = tid >> 6, r = lane & 31, h2 = lane >> 5;
  const int qpos = qi * 128 + wave * 32 + r;
  const size_t mq = (size_t)b * 2048 + qpos;
  bf16x8 qf[4];
#pragma unroll
  for (int ks = 0; ks < 4; ++ks) qf[ks] = *(const bf16x8*)(proj + mq * PS + C_SQ + h * 64 + ks * 16 + h2 * 8);
  f32x16 o[2];
#pragma unroll
  for (int i = 0; i < 16; ++i) { o[0][i] = 0.f; o[1][i] = 0.f; }
  float carry = 1.0f;
  u32x4 pk[4], pv[4];
#pragma unroll
  for (int i = 0; i < 4; ++i) {
    const int c = tid + i * 256;
    pk[i] = *(const u32x4*)(proj + ((size_t)b * 2048 + qi * 128 + (c >> 3)) * PS + C_SK + h * 64 + (c & 7) * 8);
    pv[i] = *(const u32x4*)(svt + ((size_t)((b * 8 + h) * 64 + (c >> 4))) * 2048 + qi * 128 + (c & 15) * 8);
  }
  for (int kb = qi; kb >= 0; --kb) {
    __syncthreads();
    if (kb != qi) { const volatile int* vote = (const volatile int*)(smem + 65568); if (vote[0] & vote[1] & vote[2] & vote[3]) break; }
#pragma unroll
    for (int i = 0; i < 4; ++i) {
      const int c = tid + i * 256;
      *(u32x4*)(Ks + (c >> 3) * 72 + (c & 7) * 8) = pk[i];
      *(u32x4*)(Vt + (c >> 4) * 136 + (c & 15) * 8) = pv[i];
    }
    __syncthreads();
    if (kb > 0) {
#pragma unroll
      for (int i = 0; i < 4; ++i) {
        const int c = tid + i * 256;
        pk[i] = *(const u32x4*)(proj + ((size_t)b * 2048 + (kb - 1) * 128 + (c >> 3)) * PS + C_SK + h * 64 + (c & 7) * 8);
        pv[i] = *(const u32x4*)(svt + ((size_t)((b * 8 + h) * 64 + (c >> 4))) * 2048 + (kb - 1) * 128 + (c & 15) * 8);
      }
    }
    const bool diag = (kb == qi);
    for (int kt = 3; kt >= 0; --kt) {
      f32x16 s;
#pragma unroll
      for (int i = 0; i < 16; ++i) s[i] = 0.f;
#pragma unroll
      for (int ks = 0; ks < 4; ++ks) { bf16x8 kf = *(const bf16x8*)(Ks + (kt * 32 + r) * 72 + ks * 16 + h2 * 8); s = MFMA32(kf, qf[ks], s); }
      const int keybase = kb * 128 + kt * 32 + 4 * h2;
      float kp[16];
#pragma unroll
      for (int reg = 0; reg < 16; ++reg) {
        kp[reg] = __builtin_amdgcn_rcpf(1.0f + __expf(s[reg]));
        if (diag) { const int key = keybase + (reg & 3) + 8 * (reg >> 2); kp[reg] = (key < qpos) ? kp[reg] : 1.0f; }
      }
      float G[4], Gp[4], off[4];
#pragma unroll
      for (int g = 0; g < 4; ++g) { G[g] = (kp[4 * g] * kp[4 * g + 1]) * (kp[4 * g + 2] * kp[4 * g + 3]); Gp[g] = shx(G[g], 32, lane); }
      const float T0 = G[0] * Gp[0], T1 = G[1] * Gp[1], T2 = G[2] * Gp[2], T3 = G[3] * Gp[3];
      const float st2 = T3, st1 = T3 * T2, st0 = st1 * T1, total = st0 * T0;
      off[3] = carry; off[2] = carry * st2; off[1] = carry * st1; off[0] = carry * st0;
      if (h2 == 0) { off[0] *= Gp[0]; off[1] *= Gp[1]; off[2] *= Gp[2]; off[3] *= Gp[3]; }
      f32x16 w;
#pragma unroll
      for (int g = 0; g < 4; ++g) {
        float e = off[g];
#pragma unroll
        for (int i = 3; i >= 0; --i) {
          const int reg = 4 * g + i;
          w[reg] = (1.0f - kp[reg]) * e;
          e *= kp[reg];
        }
      }
      carry *= total;
#pragma unroll
      for (int sidx = 0; sidx < 2; ++sidx) {
        const bf16x8 pf = pack_frag(w, sidx);
#pragma unroll
        for (int dt = 0; dt < 2; ++dt) {
          const bf16_t* vp = Vt + (dt * 32 + r) * 136 + kt * 32 + 16 * sidx + 4 * h2;
          const s16x4 lo = *(const s16x4*)vp, hi = *(const s16x4*)(vp + 8);
          const bf16x8 vf = __builtin_shufflevector(lo, hi, 0, 1, 2, 3, 4, 5, 6, 7);
          o[dt] = MFMA32(vf, pf, o[dt]);
        }
      }
    }
    { const int alld = __all(carry < 1e-37f); if (lane == 0) ((volatile int*)(smem + 65568))[wave] = alld ? 1 : 0; }
  }
#pragma unroll
  for (int dt = 0; dt < 2; ++dt)
#pragma unroll
    for (int gp = 0; gp < 4; gp += 2) {
      uint2 zq[2], oq[2];
      load32_pair(proj + mq * PS + C_SZ + h * 64 + dt * 32 + 8 * gp, zq[0], zq[1], h2);
#pragma unroll
      for (int q = 0; q < 2; ++q) {
        const int g = gp + q; const uint2 zz = zq[q];
        const float z0 = bf2f((bf16_t)(zz.x & 0xffff)), z1 = bf2f((bf16_t)(zz.x >> 16)), z2 = bf2f((bf16_t)(zz.y & 0xffff)), z3 = bf2f((bf16_t)(zz.y >> 16));
        oq[q].x = pack2(o[dt][4 * g] * siluf_(z0), o[dt][4 * g + 1] * siluf_(z1)); oq[q].y = pack2(o[dt][4 * g + 2] * siluf_(z2), o[dt][4 * g + 3] * siluf_(z3));
      }
      store32_pair(yb + mq * 512 + h * 64 + dt * 32 + 8 * gp, oq[0], oq[1], h2);
    }
}

DI void ret_item(const Params& p, int b, int h, int es, int part, unsigned char* smem) {
  bf16_t* Ks = (bf16_t*)smem;
  bf16_t* Vt = Ks + 64 * 136;
  bf16_t* St = Vt + 64 * 136;
  const bf16_t* proj = (const bf16_t*)(ws_op(p) + OFF_PROJ);
  const bf16_t* rvt = (const bf16_t*)(ws_op(p) + OFF_RVT);
  const bf16_t* kdt = (const bf16_t*)(ws_op(p) + OFF_KDT);
  bf16_t* ya = (bf16_t*)(ws_op(p) + OFF_YA);
  float* ssq = (float*)(ws_op(p) + OFF_SSQ);
  const int tid = tid_op(), lane = tid & 63, wave = tid >> 6, r = lane & 31, h2 = lane >> 5;
  const float lg2 = log2f(1.0f - exp2f(-5.0f - (float)h));
  const float cdec = exp2f(128.0f * lg2);
  const int il = wave * 32 + r;
  const float qdec = exp2f((float)(il + 1) * lg2);
  f32x16 st[2];
#pragma unroll
  for (int i = 0; i < 16; ++i) { st[0][i] = 0.f; st[1][i] = 0.f; }
  const size_t vrow0 = (size_t)((b * 4 + h) * 256 + es * 64);
  const size_t krow = (size_t)((b * 4 + h) * 128 + wave * 32 + r);
  const int srow = tid >> 4, skc = (tid & 15) * 8;
  if (part) {
    for (int n = 0; n < 8; ++n) {
      bf16x8 kdf[8];
#pragma unroll
      for (int ks = 0; ks < 8; ++ks) kdf[ks] = *(const bf16x8*)(kdt + krow * 2048 + n * 128 + ks * 16 + h2 * 8);
      __syncthreads();
#pragma unroll
      for (int i = 0; i < 4; ++i) { const int row = srow + i * 16; *(u32x4*)(Vt + row * 136 + skc) = *(const u32x4*)(rvt + (vrow0 + row) * 2048 + n * 128 + skc); }
      __syncthreads();
#pragma unroll
      for (int i = 0; i < 16; ++i) { st[0][i] *= cdec; st[1][i] *= cdec; }
#pragma unroll
      for (int ks = 0; ks < 8; ++ks)
#pragma unroll
        for (int et = 0; et < 2; ++et) { const bf16x8 vf = *(const bf16x8*)(Vt + (et * 32 + r) * 136 + ks * 16 + h2 * 8); st[et] = MFMA32(vf, kdf[ks], st[et]); }
    }
  }
  for (int n = part * 8; n < part * 8 + 8; ++n) {
    const size_t mq = (size_t)b * 2048 + n * 128 + il;
    bf16x8 qf[8];
#pragma unroll
    for (int ks = 0; ks < 8; ++ks) qf[ks] = *(const bf16x8*)(proj + mq * PS + C_RQ + h * 128 + ks * 16 + h2 * 8);
    __syncthreads();
#pragma unroll
    for (int et = 0; et < 2; ++et)
#pragma unroll
      for (int reg = 0; reg < 16; ++reg) St[(et * 32 + crow(reg, h2)) * 136 + wave * 32 + r] = f2bf(st[et][reg]);
#pragma unroll
    for (int i = 0; i < 4; ++i) {
      const int row = srow + i * 16;
      *(u32x4*)(Vt + row * 136 + skc) = *(const u32x4*)(rvt + (vrow0 + row) * 2048 + n * 128 + skc);
      *(u32x4*)(Ks + row * 136 + skc) = *(const u32x4*)(proj + ((size_t)b * 2048 + n * 128 + row) * PS + C_RK + h * 128 + skc);
    }
    __syncthreads();
    f32x16 o[2];
#pragma unroll
    for (int i = 0; i < 16; ++i) { o[0][i] = 0.f; o[1][i] = 0.f; }
#pragma unroll
    for (int ks = 0; ks < 8; ++ks)
#pragma unroll
      for (int et = 0; et < 2; ++et) { const bf16x8 sf = *(const bf16x8*)(St + (et * 32 + r) * 136 + ks * 16 + h2 * 8); o[et] = MFMA32(sf, qf[ks], o[et]); }
#pragma unroll
    for (int i = 0; i < 16; ++i) { o[0][i] *= qdec; o[1][i] *= qdec; }
    for (int jh = 0; jh < 2; ++jh) {
      if (jh) {
        __syncthreads();
#pragma unroll
        for (int i = 0; i < 4; ++i) {
          const int row = srow + i * 16;
          *(u32x4*)(Ks + row * 136 + skc) = *(const u32x4*)(proj + ((size_t)b * 2048 + n * 128 + 64 + row) * PS + C_RK + h * 128 + skc);
        }
        __syncthreads();
      }
      for (int kt = 0; kt < 2; ++kt) {
        const int key0 = jh * 64 + kt * 32;
        if (key0 > wave * 32 + 31) continue;
        f32x16 s;
#pragma unroll
        for (int i = 0; i < 16; ++i) s[i] = 0.f;
#pragma unroll
        for (int ks = 0; ks < 8; ++ks) { const bf16x8 kf = *(const bf16x8*)(Ks + (kt * 32 + r) * 136 + ks * 16 + h2 * 8); s = MFMA32(kf, qf[ks], s); }
#pragma unroll
        for (int reg = 0; reg < 16; ++reg) {
          const int dl = il - (key0 + crow(reg, h2));
          s[reg] = (dl >= 0) ? s[reg] * __builtin_amdgcn_exp2f((float)dl * lg2) : 0.f;
        }
#pragma unroll
        for (int sidx = 0; sidx < 2; ++sidx) {
          const bf16x8 pf = pack_frag(s, sidx);
#pragma unroll
          for (int et = 0; et < 2; ++et) {
            const bf16_t* vp = Vt + (et * 32 + r) * 136 + key0 + 16 * sidx + 4 * h2;
            const s16x4 lo = *(const s16x4*)vp, hi = *(const s16x4*)(vp + 8);
            const bf16x8 vf = __builtin_shufflevector(lo, hi, 0, 1, 2, 3, 4, 5, 6, 7);
            o[et] = MFMA32(vf, pf, o[et]);
          }
        }
      }
    }
    bf16x8 kdf[8];
#pragma unroll
    for (int ks = 0; ks < 8; ++ks) kdf[ks] = *(const bf16x8*)(kdt + krow * 2048 + n * 128 + ks * 16 + h2 * 8);
    float ss = 0.f;
#pragma unroll
    for (int i = 0; i < 16; ++i) ss += o[0][i] * o[0][i] + o[1][i] * o[1][i];
    ss += shx(ss, 32, lane);
    if (h2 == 0) ssq[mq * 16 + h * 4 + es] = ss;
#pragma unroll
    for (int et = 0; et < 2; ++et)
#pragma unroll
      for (int g = 0; g < 4; g += 2) {
        uint2 oa, ob;
        oa.x = pack2(o[et][4 * g], o[et][4 * g + 1]); oa.y = pack2(o[et][4 * g + 2], o[et][4 * g + 3]);
        ob.x = pack2(o[et][4 * g + 4], o[et][4 * g + 5]); ob.y = pack2(o[et][4 * g + 6], o[et][4 * g + 7]);
        store32_pair(ya + mq * 1024 + h * 256 + es * 64 + et * 32 + 8 * g, oa, ob, h2);
      }
#pragma unroll
    for (int i = 0; i < 16; ++i) { st[0][i] *= cdec; st[1][i] *= cdec; }
#pragma unroll
    for (int ks = 0; ks < 8; ++ks)
#pragma unroll
      for (int et = 0; et < 2; ++et) { const bf16x8 vf = *(const bf16x8*)(Vt + (et * 32 + r) * 136 + ks * 16 + h2 * 8); st[et] = MFMA32(vf, kdf[ks], st[et]); }
  }
}

DI void ret_finalize(const Params& p, int layer) {
  const bf16_t* proj = (const bf16_t*)(ws_op(p) + OFF_PROJ);
  bf16_t* ya = (bf16_t*)(ws_op(p) + OFF_YA);
  const float* ssq = (const float*)(ws_op(p) + OFF_SSQ);
  const float* gn = p.in[5] + layer * 1024;
  const int tid = tid_op();
  for (int idx = (int)blockIdx.x * 256 + tid; idx < TH * 128; idx += gridDim.x * 256) {
    const size_t tok = idx >> 7; const int c8 = (idx & 127) * 8, head = c8 >> 8;
    const float4 s4 = *(const float4*)(ssq + tok * 16 + head * 4);
    const float rstd = rsqrtf((s4.x + s4.y + s4.z + s4.w) * (1.0f / 256.0f) + EPS);
    const u32x4 ov = *(const u32x4*)(ya + tok * 1024 + c8);
    const u32x4 zv = *(const u32x4*)(proj + tok * PS + C_RZ + c8);
    const float4 g0 = *(const float4*)(gn + c8), g1 = *(const float4*)(gn + c8 + 4);
    const float gg[8] = {g0.x, g0.y, g0.z, g0.w, g1.x, g1.y, g1.z, g1.w};
    u32x4 res;
#pragma unroll
    for (int q = 0; q < 4; ++q) {
      const float o0 = bf2f((bf16_t)(ov[q] & 0xffff)), o1 = bf2f((bf16_t)(ov[q] >> 16));
      const float z0 = bf2f((bf16_t)(zv[q] & 0xffff)), z1 = bf2f((bf16_t)(zv[q] >> 16));
      res[q] = pack2(o0 * rstd * gg[2 * q] * siluf_(z0), o1 * rstd * gg[2 * q + 1] * siluf_(z1));
    }
    *(u32x4*)(ya + tok * 1024 + c8) = res;
  }
}

DI void ssm_item(const Params& p, int layer, int b, int g, unsigned char* smem) {
  float* Ss = (float*)smem;
  bf16_t* KTs = (bf16_t*)smem;
  bf16_t* Hp = (bf16_t*)(smem + 33792);
  const bf16_t* proj = (const bf16_t*)(ws_op(p) + OFF_PROJ);
  bf16_t* ycp = (bf16_t*)(ws_op(p) + OFF_YCP);
  const int gi = layer * 32 + g;
  const unsigned char* tb = ws_op(p) + OFF_SSMT + (size_t)gi * SSMT_STRIDE;
  const bf16_t* KTg = (const bf16_t*)(tb + SSMT_KT); const bf16_t* Pg = (const bf16_t*)(tb + SSMT_P); const bf16_t* Qg = (const bf16_t*)(tb + SSMT_Q);
  const float* a32 = (const float*)(tb + SSMT_A32);
  const int tid = tid_op(), lane = tid & 63, wave = tid >> 6, fr = lane & 15, kq = lane >> 4;
  const int chunk = wave * 16 + fr;
  const bf16_t* ubase = proj + ((size_t)b * 2048 + chunk * 32 + (kq >> 1)) * PS + C_CU + g * 16 + 8 * (kq & 1);
  bf16x8 ub[16];
#pragma unroll
  for (int jp = 0; jp < 16; ++jp) ub[jp] = *(const bf16x8*)(ubase + (size_t)(2 * jp) * PS);
  __syncthreads();
#pragma unroll 1
  for (int mt = 0; mt < 8; ++mt) {
    f32x4 acc = {0.f, 0.f, 0.f, 0.f};
    const bf16_t* prow = Pg + (size_t)(mt * 16 + fr) * 512 + kq * 8;
#pragma unroll
    for (int ks = 0; ks < 16; ++ks) { const bf16x8 pf = *(const bf16x8*)(prow + ks * 32); acc = MFMA16(pf, ub[ks], acc); }
    *(f32x4*)(Ss + chunk * 132 + mt * 16 + kq * 4) = acc;
  }
  __syncthreads();
  if (wave == 0) {
    const float ar = a32[lane], ai = a32[64 + lane];
    float hr = 0.f, hi = 0.f;
    for (int c = 0; c < 64; ++c) {
      Hp[c * 136 + lane] = f2bf(hr); Hp[c * 136 + 64 + lane] = f2bf(hi);
      const float sr = Ss[c * 132 + lane], si = Ss[c * 132 + 64 + lane];
      const float nr = ar * hr - ai * hi + sr, ni = ar * hi + ai * hr + si;
      hr = nr; hi = ni;
    }
  }
  __syncthreads();
  for (int c = tid; c < 1056; c += 256) *(u32x4*)(KTs + c * 8) = *(const u32x4*)(KTg + c * 8);
  __syncthreads();
  float dsk[4];
#pragma unroll
  for (int i = 0; i < 4; ++i) dsk[i] = p.in[15][layer * 512 + g * 16 + kq * 4 + i];
  const int th = kq >> 1;
  const bf16_t* ktl = KTs + fr * 16 + 8 * (kq & 1);
#pragma unroll 1
  for (int ih = 0; ih < 2; ++ih) {
    f32x4 acc[16];
#pragma unroll
    for (int ii = 0; ii < 16; ++ii) {
      acc[ii] = f32x4{0.f, 0.f, 0.f, 0.f};
      const bf16_t* qrow = Qg + (size_t)((ih * 16 + ii) * 16 + fr) * 128 + kq * 8;
#pragma unroll
      for (int ks = 0; ks < 4; ++ks) { const bf16x8 qf = *(const bf16x8*)(qrow + ks * 32); const bf16x8 hbk = *(const bf16x8*)(Hp + chunk * 136 + ks * 32 + kq * 8); acc[ii] = MFMA16(qf, hbk, acc[ii]); }
    }
    if (ih == 0) {
#pragma unroll
      for (int ii = 0; ii < 16; ++ii)
#pragma unroll
        for (int jp = 0; jp <= (ii >> 1); ++jp) {
          const int t1 = ii - 2 * jp - th + 1;
          const bf16x8 kf = *(const bf16x8*)(ktl + t1 * 256);
          acc[ii] = MFMA16(kf, ub[jp], acc[ii]);
        }
    } else {
#pragma unroll
      for (int ii = 0; ii < 16; ++ii)
#pragma unroll
        for (int jp = 0; jp <= ((16 + ii) >> 1); ++jp) {
          const int t1 = 16 + ii - 2 * jp - th + 1;
          const bf16x8 kf = *(const bf16x8*)(ktl + t1 * 256);
          acc[ii] = MFMA16(kf, ub[jp], acc[ii]);
        }
    }
#pragma unroll
    for (int ii = 0; ii < 16; ii += 2) {
      const size_t tok = (size_t)b * 2048 + chunk * 32 + ih * 16 + ii;
      uint2 uq[2], oq[2];
      load16_pair(proj + tok * PS + C_CU + g * 16, uq[0], uq[1], kq, PS);
#pragma unroll
      for (int q = 0; q < 2; ++q) {
        const uint2 uu = uq[q];
        const float y0 = gelu_tanh(acc[ii + q][0] + dsk[0] * bf2f((bf16_t)(uu.x & 0xffff)));
        const float y1 = gelu_tanh(acc[ii + q][1] + dsk[1] * bf2f((bf16_t)(uu.x >> 16)));
        const float y2 = gelu_tanh(acc[ii + q][2] + dsk[2] * bf2f((bf16_t)(uu.y & 0xffff)));
        const float y3 = gelu_tanh(acc[ii + q][3] + dsk[3] * bf2f((bf16_t)(uu.y >> 16)));
        oq[q].x = pack2(y0, y1); oq[q].y = pack2(y2, y3);
      }
      store16_pair(ycp + tok * 512 + g * 16, oq[0], oq[1], kq, 512);
    }
  }
}

DI void phase_mixers(const Params& p, int layer, int half, unsigned char* smem) {
  const int NI = 256 + 256 + 1024;
  int* ctr = (int*)(ws_op(p) + OFF_CTR) + (layer * 2 + half);
  int* s_item = (int*)(smem + 65536);
  const int tid = tid_op();
  for (;;) {
    __syncthreads();
    if (tid == 0) *s_item = atomicAdd(ctr, 1);
    __syncthreads();
    const int id = *s_item;
    if (id >= NI) break;
    if (id < 256) ssm_item(p, layer, id >> 5, id & 31, smem);
    else if (id < 512) { const int j = id - 256, q = j & 127; ret_item(p, q >> 4, (q >> 2) & 3, q & 3, 1 - (j >> 7), smem); }
    else { const int j = id - 512, r = j & 63; sb_item(p, r >> 3, r & 7, 15 - (j >> 6), smem); }
  }
}

DI void phase_glu(const Params& p, int layer, unsigned char* smem) {
  const bf16_t* ycp = (const bf16_t*)(ws_op(p) + OFF_YCP);
  const bf16_t* WT = (const bf16_t*)(ws_op(p) + OFF_WT) + (size_t)layer * LAYER_W + W_GLU_T;
  const bf16_t* proj = (const bf16_t*)(ws_op(p) + OFF_PROJ);
  bf16_t* yc = (bf16_t*)(ws_op(p) + OFF_YC);
  const float* bg = p.in[17] + layer * 512;
  const int tid_ = tid_op(), lane = tid_ & 63, wave = tid_ >> 6, wm = wave >> 1, wn = wave & 1;
  for (int t = (int)blockIdx.x; t < 128 * 4; t += gridDim.x) {
    const int m0 = (t >> 2) * 128, n0 = (t & 3) * 128;
    f32x4 acc[4][4]; zero_acc<4>(acc);
    gemm_core<true, 4>(ycp + (size_t)m0 * 512, 512, WT + (size_t)n0 * 512, 512, 512, acc, smem);
#pragma unroll
    for (int i = 0; i < 4; ++i)
#pragma unroll
      for (int jp = 0; jp < 4; jp += 2) {
        const size_t m = m0 + wm * 64 + i * 16 + (lane & 15); const int nb = n0 + wn * 64 + jp * 16;
        uint2 yq[2], zq[2], oq[2];
        load16_pair(ycp + m * 512 + nb, yq[0], yq[1], lane >> 4);
        load16_pair(proj + m * PS + C_CZ + nb, zq[0], zq[1], lane >> 4);
#pragma unroll
        for (int q = 0; q < 2; ++q) {
          const int j = jp + q; const uint2 yy = yq[q], zz = zq[q];
          const float4 b4 = *(const float4*)(bg + nb + q * 16 + (lane >> 4) * 4);
          const float y0 = bf2f((bf16_t)(yy.x & 0xffff)), y1 = bf2f((bf16_t)(yy.x >> 16)), y2 = bf2f((bf16_t)(yy.y & 0xffff)), y3 = bf2f((bf16_t)(yy.y >> 16));
          const float z0 = bf2f((bf16_t)(zz.x & 0xffff)), z1 = bf2f((bf16_t)(zz.x >> 16)), z2 = bf2f((bf16_t)(zz.y & 0xffff)), z3 = bf2f((bf16_t)(zz.y >> 16));
          oq[q].x = pack2(y0 * sigmoidf_(acc[i][j][0] + b4.x) * siluf_(z0), y1 * sigmoidf_(acc[i][j][1] + b4.y) * siluf_(z1));
          oq[q].y = pack2(y2 * sigmoidf_(acc[i][j][2] + b4.z) * siluf_(z2), y3 * sigmoidf_(acc[i][j][3] + b4.w) * siluf_(z3));
        }
        store16_pair(yc + m * 512 + nb, oq[0], oq[1], lane >> 4);
      }
  }
}

DI void phase_merge(const Params& p, int layer, unsigned char* smem) {
  const bf16_t* wl = (const bf16_t*)(ws_op(p) + OFF_WT) + (size_t)layer * LAYER_W;
  const bf16_t* ya = (const bf16_t*)(ws_op(p) + OFF_YA);
  const bf16_t* yb = (const bf16_t*)(ws_op(p) + OFF_YB);
  const bf16_t* yc = (const bf16_t*)(ws_op(p) + OFF_YC);
  const bf16_t* proj = (const bf16_t*)(ws_op(p) + OFF_PROJ);
  bf16_t* merged = (bf16_t*)(ws_op(p) + OFF_H);
  const int tid_ = tid_op(), lane = tid_ & 63, wave = tid_ >> 6, wm = wave >> 1, wn = wave & 1;
  for (int t = (int)blockIdx.x; t < 128 * 8; t += gridDim.x) {
    const int m0 = (t >> 3) * 128, n0 = (t & 7) * 128;
    f32x4 mg[4][4]; zero_acc<4>(mg);
#pragma unroll 1
    for (int br = 0; br < 3; ++br) {
      f32x4 acc[4][4]; zero_acc<4>(acc);
      if (br == 0) gemm_core<true, 4>(ya + (size_t)m0 * 1024, 1024, wl + PA_T + (size_t)n0 * 1024, 1024, 1024, acc, smem);
      else if (br == 1) gemm_core<true, 4>(yb + (size_t)m0 * 512, 512, wl + PB_T + (size_t)n0 * 512, 512, 512, acc, smem);
      else gemm_core<true, 4>(yc + (size_t)m0 * 512, 512, wl + PC_T + (size_t)n0 * 512, 512, 512, acc, smem);
      const int gcol = (br == 0) ? C_GA : (br == 1 ? C_GB : C_GC);
#pragma unroll
      for (int i = 0; i < 4; ++i)
#pragma unroll
        for (int jp = 0; jp < 4; jp += 2) {
          const size_t m = m0 + wm * 64 + i * 16 + (lane & 15);
          uint2 gq[2];
          load16_pair(proj + m * PS + gcol + n0 + wn * 64 + jp * 16, gq[0], gq[1], lane >> 4);
#pragma unroll
          for (int q = 0; q < 2; ++q) {
            const int j = jp + q; const uint2 gg = gq[q];
            mg[i][j][0] += sigmoidf_(bf2f((bf16_t)(gg.x & 0xffff))) * acc[i][j][0];
            mg[i][j][1] += sigmoidf_(bf2f((bf16_t)(gg.x >> 16))) * acc[i][j][1];
            mg[i][j][2] += sigmoidf_(bf2f((bf16_t)(gg.y & 0xffff))) * acc[i][j][2];
            mg[i][j][3] += sigmoidf_(bf2f((bf16_t)(gg.y >> 16))) * acc[i][j][3];
          }
        }
    }
#pragma unroll
    for (int i = 0; i < 4; ++i)
#pragma unroll
      for (int j = 0; j < 4; j += 2) {
        const size_t m = m0 + wm * 64 + i * 16 + (lane & 15);
        uint2 oa, ob;
        oa.x = pack2(mg[i][j][0], mg[i][j][1]); oa.y = pack2(mg[i][j][2], mg[i][j][3]);
        ob.x = pack2(mg[i][j + 1][0], mg[i][j + 1][1]); ob.y = pack2(mg[i][j + 1][2], mg[i][j + 1][3]);
        store16_pair(merged + m * 1024 + n0 + wn * 64 + j * 16, oa, ob, lane >> 4);
      }
  }
}

DI void phase_out(const Params& p, int layer, int half, unsigned char* smem) {
  const bf16_t* wl = (const bf16_t*)(ws_op(p) + OFF_WT) + (size_t)layer * LAYER_W;
  const bf16_t* merged = (const bf16_t*)(ws_op(p) + OFF_H);
  const float* xin = (layer == 0 ? p.in[0] : p.out) + (size_t)half * TH * DM;
  float* xout = p.out + (size_t)half * TH * DM;
  const int tid_ = tid_op(), lane = tid_ & 63, wave = tid_ >> 6, wm = wave >> 1, wn = wave & 1;
  for (int t = (int)blockIdx.x; t < 64 * 8; t += gridDim.x) {
    const int m0 = (t >> 3) * 256, n0 = (t & 7) * 128;
    f32x4 acc[8][4]; zero_acc8(acc);
    gemm_core256<true>(merged + (size_t)m0 * 1024, 1024, wl + WO_T + (size_t)n0 * 1024, 1024, 1024, acc, smem);
#pragma unroll
    for (int i = 0; i < 8; ++i)
#pragma unroll
      for (int j = 0; j < 4; ++j) {
        const size_t m = m0 + wm * 128 + i * 16 + (lane & 15); const int n = n0 + wn * 64 + j * 16 + (lane >> 4) * 4;
        const float4 xv = *(const float4*)(xin + m * DM + n);
        float4 ov; ov.x = xv.x + acc[i][j][0]; ov.y = xv.y + acc[i][j][1]; ov.z = xv.z + acc[i][j][2]; ov.w = xv.w + acc[i][j][3];
        *(float4*)(xout + m * DM + n) = ov;
      }
  }
}

#define XB_TMO      128
#define XB_XCNT(j)  (256  + 64 * (j))
#define XB_XSUB(j)  (1280 + 64 * (j))
#define XB_XGEN(j)  (2304 + 64 * (j))
#define XB_TOP      3328
#define XB_TOPGEN   3392
#define XCD_BAR_WORDS 3456
#define XB_SPIN_CAP (1u << 18)
DI unsigned xb_ld(unsigned* p) { return __hip_atomic_load(p, __ATOMIC_RELAXED, __HIP_MEMORY_SCOPE_AGENT); }
DI unsigned xb_add(unsigned* p, unsigned v) { return __hip_atomic_fetch_add(p, v, __ATOMIC_RELAXED, __HIP_MEMORY_SCOPE_AGENT); }
DI unsigned xb_xcc_id() { return (unsigned)__builtin_amdgcn_s_getreg((3 << 11) | 20) & 0xFu; }
#define XB_SPIN(cond, bar) do { unsigned _sp = 0; while (cond) { __builtin_amdgcn_s_sleep(1); \
    if ((++_sp & 255u) == 0u) { if (xb_ld(&(bar)[XB_TMO])) break; if (_sp > XB_SPIN_CAP) { atomicAdd(&(bar)[XB_TMO], 1u); break; } } } } while (0)
struct XcdBarrier { unsigned* bar; unsigned x; volatile unsigned* st; };
DI XcdBarrier xcd_barrier_post(unsigned* bar, volatile unsigned* st) {
  XcdBarrier b; b.bar = bar; b.x = xb_xcc_id(); b.st = st;
  if (threadIdx.x == 0) (void)xb_add(&bar[XB_XCNT(b.x)], 1u);
  return b;
}
DI void xcd_barrier_complete(unsigned* bar, unsigned x, unsigned& nloc, unsigned& nx) {
  const unsigned G = gridDim.x;
  unsigned sum, cnt, mine, sp = 0u;
  for (;;) {
    sum = 0u; cnt = 0u; mine = 0u;
#pragma unroll
    for (unsigned j = 0; j < 16; ++j) { const unsigned c = xb_ld(&bar[XB_XCNT(j)]); sum += c; cnt += (c > 0u) ? 1u : 0u; mine = (j == x) ? c : mine; }
    if (sum == G) break;
    __builtin_amdgcn_s_sleep(1);
    if ((++sp & 255u) == 0u) { if (xb_ld(&bar[XB_TMO])) break; if (sp > XB_SPIN_CAP) { atomicAdd(&bar[XB_TMO], 1u); break; } }
  }
  nloc = mine > 0u ? mine : 1u; nx = cnt > 0u ? cnt : 1u;
}
DI void xcd_barrier(const XcdBarrier& b_unused, const Params& p, unsigned char* smem) {
  XcdBarrier b; b.x = xb_xcc_id(); b.st = (volatile unsigned*)(smem + 65552); b.bar = nullptr;
  asm volatile("s_waitcnt vmcnt(0)" ::: "memory");
  __syncthreads();
  if (threadIdx.x == 0) {
    unsigned* bar = (unsigned*)(ws_op(p) + OFF_BAR);
    __builtin_amdgcn_s_waitcnt(0);
    unsigned nloc = b.st[0], nx = b.st[1];
    if (nloc == 0u) { xcd_barrier_complete(bar, b.x, nloc, nx); b.st[0] = nloc; b.st[1] = nx; }
    const unsigned old = xb_add(&bar[XB_XSUB(b.x)], 1u);
    const unsigned gen = old / nloc;
    if (old + 1u == (gen + 1u) * nloc) {
      __builtin_amdgcn_fence(__ATOMIC_RELEASE, "agent");
      asm volatile("s_waitcnt vmcnt(0)" ::: "memory");
      const unsigned og = xb_add(&bar[XB_TOP], 1u);
      const unsigned tg = og / nx;
      if (og + 1u == (tg + 1u) * nx) xb_add(&bar[XB_TOPGEN], 1u);
      else XB_SPIN(xb_ld(&bar[XB_TOPGEN]) == tg, bar);
      __builtin_amdgcn_fence(__ATOMIC_ACQUIRE, "agent");
      xb_add(&bar[XB_XGEN(b.x)], 1u);
      asm volatile("s_waitcnt vmcnt(0)" ::: "memory");
    } else {
      XB_SPIN(xb_ld(&bar[XB_XGEN(b.x)]) == gen, bar);
      __builtin_amdgcn_fence(__ATOMIC_ACQUIRE, "agent");
      asm volatile("s_waitcnt vmcnt(0)" ::: "memory");
    }
  }
  __syncthreads();
}

__global__ void __launch_bounds__(256, 2) fwd_megakernel(Params p) {
  cg::grid_group grid = cg::this_grid();
  extern __shared__ __attribute__((aligned(1024))) unsigned char smem[];
  volatile unsigned* xst = (volatile unsigned*)(smem + 65552);
  if (threadIdx.x == 0) { xst[0] = 0u; xst[1] = 0u; }
  __syncthreads();
  const XcdBarrier xb = xcd_barrier_post((unsigned*)(ws_op(p) + OFF_BAR), xst);
  phase_prologue(p, smem);
  phase_norm(p, 0, 0);
  if (p.use_cg_sync) grid.sync();
  xcd_barrier(xb, p, smem);
  for (int layer = 0; layer < 2; ++layer)
    for (int half = 0; half < 2; ++half) {
      if (layer | half) { phase_norm(p, layer, half); xcd_barrier(xb, p, smem); }
      phase_inproj(p, layer, smem);
      xcd_barrier(xb, p, smem);
      phase_mixers(p, layer, half, smem);
      xcd_barrier(xb, p, smem);
      phase_glu(p, layer, smem);
      ret_finalize(p, layer);
      xcd_barrier(xb, p, smem);
      phase_merge(p, layer, smem);
      xcd_barrier(xb, p, smem);
      phase_out(p, layer, half, smem);
      xcd_barrier(xb, p, smem);
    }
}

extern "C" void kernel_launch(void* const* d_in, const int* in_sizes, int n_in, void* d_out, int out_size, void* d_ws, size_t ws_size, hipStream_t stream) {
  static int grid_blocks = 0;
  if (grid_blocks == 0) {
    if (n_in != 22 || ws_size < WS_END) { fprintf(stderr, "kernel_launch: unexpected n_in %d or ws_size %zu (need %zu)\n", n_in, ws_size, (size_t)WS_END); grid_blocks = -1; return; }
    int dev = 0, cus = 0, per_cu = 0;
    hipGetDevice(&dev);
    hipDeviceGetAttribute(&cus, hipDeviceAttributeMultiprocessorCount, dev);
    if (hipFuncSetAttribute((const void*)fwd_megakernel, hipFuncAttributeMaxDynamicSharedMemorySize, SMEM_BYTES) != hipSuccess) { fprintf(stderr, "kernel_launch: hipFuncSetAttribute failed\n"); grid_blocks = -1; return; }
    hipOccupancyMaxActiveBlocksPerMultiprocessor(&per_cu, fwd_megakernel, 256, SMEM_BYTES);
    if (per_cu > 2) per_cu = 2;
    if (per_cu < 1) per_cu = 1;
    grid_blocks = cus * per_cu;
  }
  if (grid_blocks < 0) return;
  Params p{};
  for (int i = 0; i < 22; ++i) p.in[i] = (const float*)d_in[i];
  p.out = (float*)d_out; p.ws = (unsigned char*)d_ws; p.use_cg_sync = 0; p.pad_ = 0;
  if (hipMemsetAsync((unsigned char*)d_ws + OFF_CTR, 0, 256 + 3456 * 4, stream) != hipSuccess) { fprintf(stderr, "kernel_launch: memset of control words failed\n"); return; }
  void* args[] = {&p};
  hipError_t e = hipLaunchCooperativeKernel((void*)fwd_megakernel, dim3(grid_blocks), dim3(256), args, SMEM_BYTES, stream);
  if (e != hipSuccess) fprintf(stderr, "cooperative launch failed: %s (grid %d)\n", hipGetErrorString(e), grid_blocks);
}
```

```cpp
#include <hip/hip_runtime.h>
#include <hip/hip_cooperative_groups.h>
#include <cstdio>
#include <cstdint>
namespace cg = cooperative_groups;

typedef unsigned short bf16_t;
typedef short bf16x8 __attribute__((ext_vector_type(8)));
typedef short s16x4 __attribute__((ext_vector_type(4)));
typedef float f32x4 __attribute__((ext_vector_type(4)));
typedef float f32x16 __attribute__((ext_vector_type(16)));
typedef unsigned u32x4 __attribute__((ext_vector_type(4)));
#define DI __device__ __forceinline__
#define MFMA16(a, b, c) __builtin_amdgcn_mfma_f32_16x16x32_bf16((a), (b), (c), 0, 0, 0)
#define MFMA32(a, b, c) __builtin_amdgcn_mfma_f32_32x32x16_bf16((a), (b), (c), 0, 0, 0)

constexpr int DM = 1024, SEQ = 2048, HB = 8, TH = HB * SEQ  , PS = 7680  ;
constexpr float EPS = 1e-6f;
constexpr int C_RQ = 0, C_RK = 512, C_RZ = 1024, C_SQ = 2048, C_SK = 2560, C_SZ = 3072, C_CU = 3584, C_CZ = 4096, C_GA = 4608, C_GB = 5632, C_GC = 6656;
constexpr size_t W_IN_T = 0, W_GLU_T = 9437184, PA_T = 9699328, PB_T = 10747904, PC_T = 11272192, WO_T = 11796480, LAYER_W = 12845056;
constexpr size_t OFF_WT = 0;
constexpr size_t OFF_ROPE = 2 * LAYER_W * 2;
constexpr size_t OFF_H = OFF_ROPE + 2 * 2048 * 64 * 4;
constexpr size_t OFF_PROJ = OFF_H + (size_t)TH * 1024 * 2;
constexpr size_t OFF_RVT = OFF_PROJ + (size_t)TH * PS * 2;
constexpr size_t OFF_SVT = OFF_RVT + (size_t)8 * 4 * 256 * 2048 * 2;
constexpr size_t OFF_YA = OFF_SVT + (size_t)8 * 8 * 64 * 2048 * 2;
constexpr size_t OFF_YB = OFF_YA + (size_t)TH * 1024 * 2;
constexpr size_t OFF_YCP = OFF_YB + (size_t)TH * 512 * 2;
constexpr size_t OFF_YC = OFF_YCP + (size_t)TH * 512 * 2;
constexpr size_t OFF_KDT = OFF_YC + (size_t)TH * 512 * 2;
constexpr size_t OFF_SSQ = OFF_KDT + (size_t)8 * 4 * 128 * 2048 * 2;
constexpr size_t SSMT_KT = 0, SSMT_P = 16896, SSMT_Q = 16896 + 131072, SSMT_A32 = 16896 + 2 * 131072, SSMT_STRIDE = 16896 + 2 * 131072 + 512;
constexpr size_t OFF_SSMT = OFF_SSQ + (size_t)TH * 16 * 4;
constexpr size_t OFF_CTR = OFF_SSMT + 64 * SSMT_STRIDE;
constexpr size_t OFF_BAR = OFF_CTR + 256;
constexpr size_t WS_END = OFF_BAR + 3456 * 4;
static_assert(WS_END <= 536870912, "workspace map exceeds 4x the largest tensor");

constexpr int SMEM_BYTES = 67584;

struct Params { const float* in[22]; float* out; unsigned char* ws; int use_cg_sync; int pad_; };

DI unsigned char* ws_op(const Params& p) { size_t z = 0; asm volatile("" : "+s"(z)); return p.ws + z; }
DI float shx(float v, int k, int lane) { return __builtin_bit_cast(float, __builtin_amdgcn_ds_bpermute((lane ^ k) << 2, __builtin_bit_cast(int, v))); }
DI float bf2f(bf16_t v) { return __uint_as_float(((unsigned)v) << 16); }
DI bf16_t f2bf(float x) { unsigned u = __float_as_uint(x); u += 0x7fffu + ((u >> 16) & 1u); return (bf16_t)(u >> 16); }
DI unsigned pack2(float lo, float hi) { unsigned r; asm volatile("v_cvt_pk_bf16_f32 %0, %1, %2" : "=v"(r) : "v"(lo), "v"(hi)); return r; }
DI float sigmoidf_(float x) { return __builtin_amdgcn_rcpf(1.0f + __expf(-x)); }
DI float siluf_(float x) { return x * sigmoidf_(x); }
DI float gelu_tanh(float y) { float a = 0.7978845608028654f * (y + 0.044715f * y * y * y); float t = 1.0f - 2.0f * __builtin_amdgcn_rcpf(__expf(2.0f * a) + 1.0f); return 0.5f * y * (1.0f + t); }
DI void swap16(unsigned& a, unsigned& b) { asm volatile("v_nop\n\tv_nop\n\tv_permlane16_swap_b32 %0, %1" : "+v"(a), "+v"(b)); }
DI void store16_pair(bf16_t* rowp, uint2 a, uint2 b, int kq, int odd_off = 16) {
  swap16(a.x, b.x); swap16(a.y, b.y);
  *(u32x4*)(rowp + (kq & 1) * odd_off + (kq >> 1) * 8) = u32x4{a.x, a.y, b.x, b.y};
}
DI void store16_pair_nt(bf16_t* rowp, uint2 a, uint2 b, int kq, int odd_off = 16) {
  swap16(a.x, b.x); swap16(a.y, b.y);
  __builtin_nontemporal_store(u32x4{a.x, a.y, b.x, b.y}, (u32x4*)(rowp + (kq & 1) * odd_off + (kq >> 1) * 8));
}
DI void load16_pair(const bf16_t* rowp, uint2& a, uint2& b, int kq, int odd_off = 16) {
  const u32x4 v = *(const u32x4*)(rowp + (kq & 1) * odd_off + (kq >> 1) * 8);
  a.x = v[0]; a.y = v[1]; b.x = v[2]; b.y = v[3];
  swap16(a.x, b.x); swap16(a.y, b.y);
}
DI void swap32(unsigned& a, unsigned& b) { asm volatile("v_nop\n\tv_nop\n\tv_permlane32_swap_b32 %0, %1" : "+v"(a), "+v"(b)); }
DI void store32_pair(bf16_t* p8  , uint2 a, uint2 b, int h2) {
  swap32(a.x, b.x); swap32(a.y, b.y);
  *(u32x4*)(p8 + h2 * 8) = u32x4{a.x, a.y, b.x, b.y};
}
DI void load32_pair(const bf16_t* p8, uint2& a, uint2& b, int h2) {
  const u32x4 v = *(const u32x4*)(p8 + h2 * 8);
  a.x = v[0]; a.y = v[1]; b.x = v[2]; b.y = v[3];
  swap32(a.x, b.x); swap32(a.y, b.y);
}
DI int crow(int reg, int h2) { return (reg & 3) + 8 * (reg >> 2) + 4 * h2; }
DI int tid_op() { int t = threadIdx.x; asm volatile("" : "+v"(t)); return t; }
struct Params;
DI unsigned char* ws_op(const Params& p);

constexpr int BK = 64;
DI int lds_byte2(int r, int c) { const int st = (r >> 4) * 2 + (c >> 5), ob = (r & 15) * 64 + (c & 31) * 2; return st * 1024 + (ob ^ (((ob >> 9) & 1) << 5)); }
DI void stage_rc2(int b, int& R, int& C) { const int st = b >> 10, sb = b & 1023, swz = sb ^ (((sb >> 9) & 1) << 5); R = (st >> 1) * 16 + (swz >> 6); C = (st & 1) * 32 + ((swz & 63) >> 1); }
#define WAIT_VM0() asm volatile("s_waitcnt vmcnt(0)" ::: "memory")
template <bool SWAP, int NJ>
DI void gemm_core(const bf16_t* __restrict__ A, int lda, const bf16_t* __restrict__ Bt, int ldb, int K, f32x4 (&acc)[4][NJ], unsigned char* sm, bool pre = false) {
  const int tid = tid_op(), lane = tid & 63, wid = tid >> 6, wm = wid >> 1, wn = wid & 1, fr = lane & 15, fq = lane >> 4;
  int aoff[4], boff[NJ];
#pragma unroll
  for (int i = 0; i < 4; ++i) { int R, C; stage_rc2(wid * 1024 + i * 4096 + lane * 16, R, C); aoff[i] = R * lda + C; }
#pragma unroll
  for (int i = 0; i < NJ; ++i) { int R, C; stage_rc2(wid * 1024 + i * 4096 + lane * 16, R, C); boff[i] = R * ldb + C; }
  const int lo = (fr * 64 + fq * 16) ^ ((fr >> 3) << 5);
  const int nt = K / BK;
  if (!pre) {
    __syncthreads();
#pragma unroll
    for (int i = 0; i < 4; ++i) __builtin_amdgcn_global_load_lds((const unsigned*)(A + aoff[i]), (__attribute__((address_space(3))) unsigned*)(sm + wid * 1024 + i * 4096), 16, 0, 0);
#pragma unroll
    for (int i = 0; i < NJ; ++i) __builtin_amdgcn_global_load_lds((const unsigned*)(Bt + boff[i]), (__attribute__((address_space(3))) unsigned*)(sm + 16384 + wid * 1024 + i * 4096), 16, 0, 0);
  }
  WAIT_VM0();
  __syncthreads();
  for (int t = 0; t < nt; ++t) {
    unsigned char* cur = sm + (t & 1) * 32768;
    unsigned char* nxt = sm + ((t & 1) ^ 1) * 32768;
    if (t + 1 < nt) {
      const int ko = (t + 1) * BK;
#pragma unroll
      for (int i = 0; i < 4; ++i) __builtin_amdgcn_global_load_lds((const unsigned*)(A + aoff[i] + ko), (__attribute__((address_space(3))) unsigned*)(nxt + wid * 1024 + i * 4096), 16, 0, 0);
#pragma unroll
      for (int i = 0; i < NJ; ++i) __builtin_amdgcn_global_load_lds((const unsigned*)(Bt + boff[i] + ko), (__attribute__((address_space(3))) unsigned*)(nxt + 16384 + wid * 1024 + i * 4096), 16, 0, 0);
    }
    bf16x8 af[2][4], bfr[2][NJ];
#pragma unroll
    for (int ks = 0; ks < 2; ++ks) {
#pragma unroll
      for (int i = 0; i < 4; ++i) af[ks][i] = *(const bf16x8*)(cur + ((wm * 4 + i) * 2 + ks) * 1024 + lo);
#pragma unroll
      for (int j = 0; j < NJ; ++j) bfr[ks][j] = *(const bf16x8*)(cur + 16384 + ((wn * NJ + j) * 2 + ks) * 1024 + lo);
      __builtin_amdgcn_sched_barrier(0);
    }
#pragma unroll
    for (int ks = 0; ks < 2; ++ks) {
#pragma unroll
      for (int i = 0; i < 4; ++i)
#pragma unroll
        for (int j = 0; j < NJ; ++j) acc[i][j] = SWAP ? MFMA16(bfr[ks][j], af[ks][i], acc[i][j]) : MFMA16(af[ks][i], bfr[ks][j], acc[i][j]);
      __builtin_amdgcn_sched_barrier(0);
    }
    WAIT_VM0();
    __syncthreads();
  }
}

DI void gemm_issue0(const bf16_t* __restrict__ A, int lda, const bf16_t* __restrict__ Bt, int ldb, unsigned char* sm) {
  const int tid = tid_op(), lane = tid & 63, wid = tid >> 6;
#pragma unroll
  for (int i = 0; i < 4; ++i) {
    int R, C; stage_rc2(wid * 1024 + i * 4096 + lane * 16, R, C);
    __builtin_amdgcn_global_load_lds((const unsigned*)(A + R * lda + C), (__attribute__((address_space(3))) unsigned*)(sm + wid * 1024 + i * 4096), 16, 0, 0);
    __builtin_amdgcn_global_load_lds((const unsigned*)(Bt + R * ldb + C), (__attribute__((address_space(3))) unsigned*)(sm + 16384 + wid * 1024 + i * 4096), 16, 0, 0);
  }
}
template <bool SWAP>
DI void gemm_core256(const bf16_t* __restrict__ A, int lda, const bf16_t* __restrict__ Bt, int ldb, int K, f32x4 (&acc)[8][4], unsigned char* sm) {
  const int tid = tid_op(), lane = tid & 63, wid = tid >> 6, wm = wid >> 1, wn = wid & 1, fr = lane & 15, fq = lane >> 4;
  int aoff[4], boff[2];
#pragma unroll
  for (int i = 0; i < 4; ++i) { const int b = wid * 1024 + i * 4096 + lane * 16, R = b >> 6, c = ((b >> 4) & 3) ^ ((-(R >> 2)) & 3); aoff[i] = R * lda + c * 8; }
#pragma unroll
  for (int i = 0; i < 2; ++i) { const int b = wid * 1024 + i * 4096 + lane * 16, R = b >> 6, c = ((b >> 4) & 3) ^ ((-(R >> 2)) & 3); boff[i] = R * ldb + c * 8; }
  const int lo = fr * 64 + ((fq ^ ((-(fr >> 2)) & 3)) << 4);
  const int nt = K / 32;
  __syncthreads();
#pragma unroll
  for (int i = 0; i < 4; ++i) __builtin_amdgcn_global_load_lds((const unsigned*)(A + aoff[i]), (__attribute__((address_space(3))) unsigned*)(sm + wid * 1024 + i * 4096), 16, 0, 0);
#pragma unroll
  for (int i = 0; i < 2; ++i) __builtin_amdgcn_global_load_lds((const unsigned*)(Bt + boff[i]), (__attribute__((address_space(3))) unsigned*)(sm + 16384 + wid * 1024 + i * 4096), 16, 0, 0);
  WAIT_VM0();
  __syncthreads();
  for (int t = 0; t < nt; ++t) {
    unsigned char* cur = sm + (t & 1) * 24576;
    unsigned char* nxt = sm + ((t & 1) ^ 1) * 24576;
    if (t + 1 < nt) {
      const int ko = (t + 1) * 32;
#pragma unroll
      for (int i = 0; i < 4; ++i) __builtin_amdgcn_global_load_lds((const unsigned*)(A + aoff[i] + ko), (__attribute__((address_space(3))) unsigned*)(nxt + wid * 1024 + i * 4096), 16, 0, 0);
#pragma unroll
      for (int i = 0; i < 2; ++i) __builtin_amdgcn_global_load_lds((const unsigned*)(Bt + boff[i] + ko), (__attribute__((address_space(3))) unsigned*)(nxt + 16384 + wid * 1024 + i * 4096), 16, 0, 0);
    }
    bf16x8 af[8], bfr[4];
#pragma unroll
    for (int i = 0; i < 8; ++i) af[i] = *(const bf16x8*)(cur + (wm * 8 + i) * 1024 + lo);
#pragma unroll
    for (int j = 0; j < 4; ++j) bfr[j] = *(const bf16x8*)(cur + 16384 + (wn * 4 + j) * 1024 + lo);
    __builtin_amdgcn_sched_barrier(0);
#pragma unroll
    for (int i = 0; i < 8; ++i)
#pragma unroll
      for (int j = 0; j < 4; ++j) acc[i][j] = SWAP ? MFMA16(bfr[j], af[i], acc[i][j]) : MFMA16(af[i], bfr[j], acc[i][j]);
    __builtin_amdgcn_sched_barrier(0);
    WAIT_VM0();
    __syncthreads();
  }
}
DI void zero_acc8(f32x4 (&acc)[8][4]) {
#pragma unroll
  for (int i = 0; i < 8; ++i)
#pragma unroll
    for (int j = 0; j < 4; ++j) acc[i][j] = f32x4{0.f, 0.f, 0.f, 0.f};
}
template <int NJ>
DI void zero_acc(f32x4 (&acc)[4][NJ]) {
#pragma unroll
  for (int i = 0; i < 4; ++i)
#pragma unroll
    for (int j = 0; j < NJ; ++j) acc[i][j] = f32x4{0.f, 0.f, 0.f, 0.f};
}

DI void transpose_tile(const float* __restrict__ W, int K, int N, bf16_t* __restrict__ WT, int tile, float* sm) {
  const int tid = tid_op();
  const int ntn = N >> 6, kt = tile / ntn, nt = tile % ntn;
  __syncthreads();
#pragma unroll
  for (int i = 0; i < 4; ++i) {
    int idx = tid + i * 256, row = idx >> 4, c4 = (idx & 15) * 4;
    float4 v = *(const float4*)(W + (size_t)(kt * 64 + row) * N + nt * 64 + c4);
    sm[row * 65 + c4 + 0] = v.x; sm[row * 65 + c4 + 1] = v.y; sm[row * 65 + c4 + 2] = v.z; sm[row * 65 + c4 + 3] = v.w;
  }
  __syncthreads();
  const int n = tid >> 2, kq = (tid & 3) * 16;
  unsigned pk[8];
#pragma unroll
  for (int i = 0; i < 8; ++i) pk[i] = pack2(sm[(kq + 2 * i) * 65 + n], sm[(kq + 2 * i + 1) * 65 + n]);
  uint4* dst = (uint4*)(WT + (size_t)(nt * 64 + n) * K + kt * 64 + kq);
  dst[0] = uint4{pk[0], pk[1], pk[2], pk[3]};
  dst[1] = uint4{pk[4], pk[5], pk[6], pk[7]};
}

DI void ssm_tables(const Params& p, int layer, int g, float* sm, int part, int nparts) {
  float* pwr = sm; float* pwi = pwr + 33 * 64; float* bbr = pwi + 33 * 64; float* bbi = bbr + 1024; float* cr = bbi + 1024; float* ci = cr + 1024;
  const int tid = tid_op(), gi = layer * 32 + g;
  unsigned char* tb = ws_op(p) + OFF_SSMT + (size_t)gi * SSMT_STRIDE;
  __syncthreads();
  if (tid < 64) {
    const float a_re = p.in[8][gi * 64 + tid], a_im = p.in[9][gi * 64 + tid];
    const float dt = expf(p.in[10][gi]);
    const float mag = expf(dt * a_re);
    const float abr = mag * cosf(dt * a_im), abi = mag * sinf(dt * a_im);
    const float den = a_re * a_re + a_im * a_im, nr = abr - 1.0f;
    const float cfr = (nr * a_re + abi * a_im) / den, cfi = (abi * a_re - nr * a_im) / den;
    const float* bre = p.in[11] + ((size_t)gi * 64 + tid) * 16;
    const float* bim = p.in[12] + ((size_t)gi * 64 + tid) * 16;
    for (int m = 0; m < 16; ++m) { const float br = bre[m], bi = bim[m]; bbr[tid * 16 + m] = cfr * br - cfi * bi; bbi[tid * 16 + m] = cfr * bi + cfi * br; }
    float pr = 1.0f, pi = 0.0f;
    for (int t = 0; t <= 32; ++t) { pwr[t * 64 + tid] = pr; pwi[t * 64 + tid] = pi; const float nr2 = pr * abr - pi * abi, ni2 = pr * abi + pi * abr; pr = nr2; pi = ni2; }
    float* a32 = (float*)(tb + SSMT_A32);
    if (part == 0) { a32[tid] = pwr[32 * 64 + tid]; a32[64 + tid] = pwi[32 * 64 + tid]; }
  }
  for (int idx = tid; idx < 1024; idx += 256) { cr[idx] = p.in[13][(size_t)gi * 1024 + idx]; ci[idx] = p.in[14][(size_t)gi * 1024 + idx]; }
  __syncthreads();
  bf16_t* KT = (bf16_t*)(tb + SSMT_KT); bf16_t* P = (bf16_t*)(tb + SSMT_P); bf16_t* Q = (bf16_t*)(tb + SSMT_Q);
  for (int idx = tid + part * 256; idx < 33 * 256; idx += 256 * nparts) {
    const int t1 = idx >> 8, m = (idx >> 4) & 15, mp = idx & 15;
    float acc = 0.f;
    if (t1 > 0) {
      const int t = t1 - 1;
      for (int q = 0; q < 64; ++q) {
        const float ar = pwr[t * 64 + q], ai = pwi[t * 64 + q], br = bbr[q * 16 + mp], bi = bbi[q * 16 + mp];
        acc += cr[m * 64 + q] * (ar * br - ai * bi) - ci[m * 64 + q] * (ar * bi + ai * br);
      }
    }
    KT[idx] = f2bf(acc);
  }
  for (int idx = tid + part * 256; idx < 128 * 512; idx += 256 * nparts) {
    const int pp = idx >> 9, k = idx & 511, j = k >> 4, mp = k & 15, q = pp & 63, e = 31 - j;
    const float ar = pwr[e * 64 + q], ai = pwi[e * 64 + q], br = bbr[q * 16 + mp], bi = bbi[q * 16 + mp];
    P[idx] = f2bf(pp < 64 ? (ar * br - ai * bi) : (ar * bi + ai * br));
  }
  for (int idx = tid + part * 256; idx < 512 * 128; idx += 256 * nparts) {
    const int row = idx >> 7, pp = idx & 127, i = row >> 4, m = row & 15, q = pp & 63;
    const float ar = pwr[(i + 1) * 64 + q], ai = pwi[(i + 1) * 64 + q], c_r = cr[m * 64 + q], c_i = ci[m * 64 + q];
    Q[idx] = f2bf(pp < 64 ? (c_r * ar - c_i * ai) : (-c_r * ai - c_i * ar));
  }
}

struct TrTask { const float* W; bf16_t* WT; int K, N, tile; };
DI TrTask tr_resolve(const Params& p, int u) {
  const int layer = u / 3136, r = u % 3136;
  bf16_t* wl = (bf16_t*)(ws_op(p) + OFF_WT) + (size_t)layer * LAYER_W;
  TrTask t;
  if (r < 2304) { t.W = p.in[2] + (size_t)layer * 1024 * 9216; t.K = 1024; t.N = 9216; t.WT = wl + W_IN_T; t.tile = r; }
  else if (r < 2368) { t.W = p.in[16] + (size_t)layer * 512 * 512; t.K = 512; t.N = 512; t.WT = wl + W_GLU_T; t.tile = r - 2304; }
  else if (r < 2624) { t.W = p.in[18] + (size_t)layer * 1024 * 1024; t.K = 1024; t.N = 1024; t.WT = wl + PA_T; t.tile = r - 2368; }
  else if (r < 2752) { t.W = p.in[19] + (size_t)layer * 512 * 1024; t.K = 512; t.N = 1024; t.WT = wl + PB_T; t.tile = r - 2624; }
  else if (r < 2880) { t.W = p.in[20] + (size_t)layer * 512 * 1024; t.K = 512; t.N = 1024; t.WT = wl + PC_T; t.tile = r - 2752; }
  else { t.W = p.in[21] + (size_t)layer * 1024 * 1024; t.K = 1024; t.N = 1024; t.WT = wl + WO_T; t.tile = r - 2880; }
  return t;
}
DI void tr_load(const TrTask& t, int tid, f32x4 (&v)[4]) {
  const int ntn = t.N >> 6, kt = t.tile / ntn, nt = t.tile % ntn;
#pragma unroll
  for (int i = 0; i < 4; ++i) { const int idx = tid + i * 256, row = idx >> 4, c4 = (idx & 15) * 4; v[i] = __builtin_nontemporal_load((const f32x4*)(t.W + (size_t)(kt * 64 + row) * t.N + nt * 64 + c4)); }
}
DI void tr_finish(const TrTask& t, int tid, const f32x4 (&v)[4], float* sm) {
  const int ntn = t.N >> 6, kt = t.tile / ntn, nt = t.tile % ntn;
  __syncthreads();
#pragma unroll
  for (int i = 0; i < 4; ++i) { const int idx = tid + i * 256, row = idx >> 4, c4 = (idx & 15) * 4; sm[row * 65 + c4 + 0] = v[i][0]; sm[row * 65 + c4 + 1] = v[i][1]; sm[row * 65 + c4 + 2] = v[i][2]; sm[row * 65 + c4 + 3] = v[i][3]; }
  __syncthreads();
  const int n = tid >> 2, kq = (tid & 3) * 16;
  u32x4 lo, hi;
#pragma unroll
  for (int i = 0; i < 4; ++i) { lo[i] = pack2(sm[(kq + 2 * i) * 65 + n], sm[(kq + 2 * i + 1) * 65 + n]); hi[i] = pack2(sm[(kq + 8 + 2 * i) * 65 + n], sm[(kq + 9 + 2 * i) * 65 + n]); }
  u32x4* dst = (u32x4*)(t.WT + (size_t)(nt * 64 + n) * t.K + kt * 64 + kq);
  dst[0] = lo; dst[1] = hi;
}

DI void phase_prologue(const Params& p, unsigned char* smem) {
  float* sm = (float*)smem;
  const int tid = tid_op();
  const int G = (int)gridDim.x, bid = (int)blockIdx.x;
  for (int q = bid; q < 256; q += G) ssm_tables(p, q >> 7, (q >> 2) & 31, sm, q & 3, 4);
  {
    int u = bid;
    f32x4 cur[4], nxt[4];
    if (u < 2 * 3136) { const TrTask t0 = tr_resolve(p, u); tr_load(t0, tid, cur); }
    for (; u < 2 * 3136; u += G) {
      const int un = u + G;
      if (un < 2 * 3136) { const TrTask tn = tr_resolve(p, un); tr_load(tn, tid, nxt); }
      const TrTask t = tr_resolve(p, u);
      tr_finish(t, tid, cur, sm);
#pragma unroll
      for (int i = 0; i < 4; ++i) cur[i] = nxt[i];
    }
  }
  for (int r = bid; r < 512; r += G) {
    const int idx = r * 256 + tid;
    const int pos = idx >> 6, i = idx & 63;
    const float inv = exp2f(-(float)i * (13.287712379549449f / 64.0f));
    const float ang = (float)pos * inv;
    float* cosT = (float*)(ws_op(p) + OFF_ROPE); float* sinT = cosT + 2048 * 64;
    cosT[idx] = cosf(ang); sinT[idx] = sinf(ang);
  }
}

DI void phase_norm(const Params& p, int layer, int half) {
  const float* xin = (layer == 0 ? p.in[0] : p.out) + (size_t)half * TH * DM;
  const float* g = p.in[1] + layer * DM;
  bf16_t* h = (bf16_t*)(ws_op(p) + OFF_H);
  const int tid_ = tid_op(), lane = tid_ & 63, wave = tid_ >> 6;
  for (int row = (int)blockIdx.x * 4 + wave; row < TH; row += gridDim.x * 4) {
    const float* xr = xin + (size_t)row * DM;
    float4 v[4]; float ss = 0.f;
#pragma unroll
    for (int i = 0; i < 4; ++i) { v[i] = *(const float4*)(xr + i * 256 + lane * 4); ss += v[i].x * v[i].x + v[i].y * v[i].y + v[i].z * v[i].z + v[i].w * v[i].w; }
#pragma unroll
    for (int o = 32; o >= 1; o >>= 1) ss += shx(ss, o, lane);
    const float rstd = rsqrtf(ss * (1.0f / 1024.0f) + EPS);
#pragma unroll
    for (int i = 0; i < 4; ++i) {
      float4 g4 = *(const float4*)(g + i * 256 + lane * 4);
      uint2 o2; o2.x = pack2(v[i].x * rstd * g4.x, v[i].y * rstd * g4.y); o2.y = pack2(v[i].z * rstd * g4.z, v[i].w * rstd * g4.w);
      *(uint2*)(h + (size_t)row * DM + i * 256 + lane * 4) = o2;
    }
  }
}

DI void phase_inproj(const Params& p, int layer, unsigned char* smem) {
  const bf16_t* h = (const bf16_t*)(ws_op(p) + OFF_H);
  const bf16_t* WinT = (const bf16_t*)(ws_op(p) + OFF_WT) + (size_t)layer * LAYER_W + W_IN_T;
  bf16_t* proj = (bf16_t*)(ws_op(p) + OFF_PROJ);
  bf16_t* rvt = (bf16_t*)(ws_op(p) + OFF_RVT);
  bf16_t* svt = (bf16_t*)(ws_op(p) + OFF_SVT);
  const int tid_ = tid_op(), lane = tid_ & 63, wave = tid_ >> 6, wm = wave >> 1, wn = wave & 1;
  bool pre = false;
  for (int t = (int)blockIdx.x; t < 128 * 72; t += gridDim.x) {
    const int mt = t / 72, nt = t % 72, m0 = mt * 128, n0 = nt * 128;
    f32x4 acc[4][4]; zero_acc<4>(acc);
    const bool isrv = (n0 >= 1024 && n0 < 2048), issv = (n0 >= 4096 && n0 < 4608);
    const int tn = t + (int)gridDim.x;
    const bool chain = (tn < 128 * 72) && (isrv || issv || n0 >= 1024);
    const bf16_t* An = h + (size_t)((tn / 72) * 128) * DM; const bf16_t* Bn = WinT + (size_t)((tn % 72) * 128) * DM;
    if (isrv || issv) {
      gemm_core<false, 4>(h + (size_t)m0 * DM, DM, WinT + (size_t)n0 * DM, DM, DM, acc, smem, pre);
      pre = chain;
      if (chain) gemm_issue0(An, DM, Bn, DM, smem);
#pragma unroll
      for (int i = 0; i < 4; i += 2)
#pragma unroll
        for (int j = 0; j < 4; ++j) {
          const int mb = m0 + wm * 64 + i * 16, n = n0 + wn * 64 + j * 16 + (lane & 15);
          const int bl = mb >> 11, s = mb & 2047;
          uint2 oa, ob;
          oa.x = pack2(acc[i][j][0], acc[i][j][1]); oa.y = pack2(acc[i][j][2], acc[i][j][3]);
          ob.x = pack2(acc[i + 1][j][0], acc[i + 1][j][1]); ob.y = pack2(acc[i + 1][j][2], acc[i + 1][j][3]);
          bf16_t* rowp;
          if (isrv) { const int c = n - 1024, hh = c >> 8, dv = c & 255; rowp = rvt + ((size_t)((bl * 4 + hh) * 256 + dv)) * 2048 + s; }
          else { const int c = n - 4096, hh = c >> 6, dv = c & 63; rowp = svt + ((size_t)((bl * 8 + hh) * 64 + dv)) * 2048 + s; }
          store16_pair_nt(rowp, oa, ob, lane >> 4);
        }
    } else {
      gemm_core<true, 4>(h + (size_t)m0 * DM, DM, WinT + (size_t)n0 * DM, DM, DM, acc, smem, pre);
      pre = chain;
      if (chain) gemm_issue0(An, DM, Bn, DM, smem);
      const int shift = (n0 >= 2048 ? 1024 : 0) + (n0 >= 4608 ? 512 : 0);
      const int fr = lane & 15, kq = lane >> 4;
      if (n0 >= 3072 && n0 < 4096) {
        const bool isq = n0 < 3584;
        const float* gain = (isq ? p.in[6] : p.in[7]) + layer * 64;
#pragma unroll
        for (int i = 0; i < 4; ++i) {
          float ss = 0.f;
#pragma unroll
          for (int j = 0; j < 4; ++j) ss += acc[i][j][0] * acc[i][j][0] + acc[i][j][1] * acc[i][j][1] + acc[i][j][2] * acc[i][j][2] + acc[i][j][3] * acc[i][j][3];
          ss += shx(ss, 16, lane); ss += shx(ss, 32, lane);
          const float rs = rsqrtf(ss * (1.0f / 64.0f) + EPS) * (isq ? 0.125f : 1.0f);
#pragma unroll
          for (int j = 0; j < 4; ++j) { const float4 g4 = *(const float4*)(gain + j * 16 + kq * 4); acc[i][j][0] *= rs * g4.x; acc[i][j][1] *= rs * g4.y; acc[i][j][2] *= rs * g4.z; acc[i][j][3] *= rs * g4.w; }
        }
      } else if (n0 < 1024) {
        const bool isq = n0 < 512;
        const int hk = (n0 & 511) >> 7;
        const float* gain = (isq ? p.in[3] : p.in[4]) + layer * 128 + wn * 64;
        float* xv = (float*)smem;
        float* ssx = (float*)(smem + 65600);
        const float* cosT = (const float*)(ws_op(p) + OFF_ROPE); const float* sinT = cosT + 2048 * 64;
        float ssp[4];
#pragma unroll
        for (int i = 0; i < 4; ++i) {
          float ss = 0.f;
#pragma unroll
          for (int j = 0; j < 4; ++j) ss += acc[i][j][0] * acc[i][j][0] + acc[i][j][1] * acc[i][j][1] + acc[i][j][2] * acc[i][j][2] + acc[i][j][3] * acc[i][j][3];
          ss += shx(ss, 16, lane); ss += shx(ss, 32, lane);
          ssp[i] = ss;
          if (kq == 0) ssx[wave * 64 + i * 16 + fr] = ss;
        }
        __syncthreads();
#pragma unroll
        for (int i = 0; i < 4; ++i) {
          const float rs = rsqrtf((ssp[i] + ssx[(wave ^ 1) * 64 + i * 16 + fr]) * (1.0f / 128.0f) + EPS);
#pragma unroll
          for (int j = 0; j < 4; ++j) {
            const float4 g4 = *(const float4*)(gain + j * 16 + kq * 4);
            acc[i][j][0] *= rs * g4.x; acc[i][j][1] *= rs * g4.y; acc[i][j][2] *= rs * g4.z; acc[i][j][3] *= rs * g4.w;
#pragma unroll
            for (int r = 0; r < 4; ++r) xv[wave * 4096 + ((i * 4 + j) * 4 + r) * 64 + lane] = acc[i][j][r];
          }
        }
        __syncthreads();
        const float sgn = wn ? 1.0f : -1.0f, ksc = isq ? 1.0f : 0.08838834764831845f;
        const float lg2k = log2f(1.0f - exp2f(-5.0f - (float)hk));
#pragma unroll
        for (int i = 0; i < 4; ++i) {
          const int m = m0 + wm * 64 + i * 16 + fr, pos = m & 2047;
          const float kd = exp2f((float)(127 - (pos & 127)) * lg2k);
          bf16_t* kdst = (bf16_t*)(ws_op(p) + OFF_KDT) + ((size_t)(((m >> 11) * 4 + hk) * 128 + wn * 64)) * 2048 + pos;
#pragma unroll
          for (int j = 0; j < 4; ++j) {
            const float4 c4 = *(const float4*)(cosT + pos * 64 + j * 16 + kq * 4), s4 = *(const float4*)(sinT + pos * 64 + j * 16 + kq * 4);
            const float cc[4] = {c4.x, c4.y, c4.z, c4.w}, sn[4] = {s4.x, s4.y, s4.z, s4.w};
#pragma unroll
            for (int r = 0; r < 4; ++r) {
              const float other = xv[(wave ^ 1) * 4096 + ((i * 4 + j) * 4 + r) * 64 + lane];
              const float o = (acc[i][j][r] * cc[r] + sgn * other * sn[r]) * ksc;
              acc[i][j][r] = o;
              if (!isq) kdst[(size_t)(j * 16 + kq * 4 + r) * 2048] = f2bf(o * kd);
            }
            uint2 o2; o2.x = pack2(acc[i][j][0], acc[i][j][1]); o2.y = pack2(acc[i][j][2], acc[i][j][3]);
            *(uint2*)(proj + (size_t)m * PS + n0 + wn * 64 + j * 16 + kq * 4) = o2;
          }
        }
        continue;
      }
#pragma unroll
      for (int i = 0; i < 4; ++i)
#pragma unroll
        for (int j = 0; j < 4; j += 2) {
          const int m = m0 + wm * 64 + i * 16 + (lane & 15);
          uint2 oa, ob;
          oa.x = pack2(acc[i][j][0], acc[i][j][1]); oa.y = pack2(acc[i][j][2], acc[i][j][3]);
          ob.x = pack2(acc[i][j + 1][0], acc[i][j + 1][1]); ob.y = pack2(acc[i][j + 1][2], acc[i][j + 1][3]);
          store16_pair_nt(proj + (size_t)m * PS + n0 - shift + wn * 64 + j * 16, oa, ob, lane >> 4);
        }
    }
  }
}

DI bf16x8 pack_frag(const f32x16& x, int s) {
  u32x4 p;
  asm volatile("v_cvt_pk_bf16_f32 %0, %4, %5\n\tv_cvt_pk_bf16_f32 %1, %6, %7\n\tv_cvt_pk_bf16_f32 %2, %8, %9\n\tv_cvt_pk_bf16_f32 %3, %10, %11\n\ts_nop 1"
               : "=&v"(p[0]), "=&v"(p[1]), "=&v"(p[2]), "=&v"(p[3])
               : "v"(x[8 * s]), "v"(x[8 * s + 1]), "v"(x[8 * s + 2]), "v"(x[8 * s + 3]), "v"(x[8 * s + 4]), "v"(x[8 * s + 5]), "v"(x[8 * s + 6]), "v"(x[8 * s + 7]));
  return __builtin_bit_cast(bf16x8, p);
}

DI void sb_item(const Params& p, int b, int h, int qi, unsigned char* smem) {
  bf16_t* Ks = (bf16_t*)smem;
  bf16_t* Vt = Ks + 128 * 72;
  const bf16_t* proj = (const bf16_t*)(ws_op(p) + OFF_PROJ);
  const bf16_t* svt = (const bf16_t*)(ws_op(p) + OFF_SVT);
  bf16_t* yb = (bf16_t*)(ws_op(p) + OFF_YB);
  const int tid = tid_op(), lane = tid & 63, wave = tid >> 6, r = lane & 31, h2 = lane >> 5;
  const int qpos = qi * 128 + wave * 32 + r;
  const size_t mq = (size_t)b * 2048 + qpos;
  bf16x8 qf[4];
#pragma unroll
  for (int ks = 0; ks < 4; ++ks) qf[ks] = *(const bf16x8*)(proj + mq * PS + C_SQ + h * 64 + ks * 16 + h2 * 8);
  f32x16 o[2];
#pragma unroll
  for (int i = 0; i < 16; ++i) { o[0][i] = 0.f; o[1][i] = 0.f; }
  float carry = 1.0f;
  u32x4 pk[4], pv[4];
#pragma unroll
  for (int i = 0; i < 4; ++i) {
    const int c = tid + i * 256;
    pk[i] = *(const u32x4*)(proj + ((size_t)b * 2048 + qi * 128 + (c >> 3)) * PS + C_SK + h * 64 + (c & 7) * 8);
    pv[i] = *(const u32x4*)(svt + ((size_t)((b * 8 + h) * 64 + (c >> 4))) * 2048 + qi * 128 + (c & 15) * 8);
  }
  for (int kb = qi; kb >= 0; --kb) {
    __syncthreads();
    if (kb != qi) { const volatile int* vote = (const volatile int*)(smem + 65568); if (vote[0] & vote[1] & vote[2] & vote[3]) break; }
#pragma unroll
    for (int i = 0; i < 4; ++i) {
      const int c = tid + i * 256;
      *(u32x4*)(Ks + (c >> 3) * 72 + (c & 7) * 8) = pk[i];
      *(u32x4*)(Vt + (c >> 4) * 136 + (c & 15) * 8) = pv[i];
    }
    __syncthreads();
    if (kb > 0) {
#pragma unroll
      for (int i = 0; i < 4; ++i) {
        const int c = tid + i * 256;
        pk[i] = *(const u32x4*)(proj + ((size_t)b * 2048 + (kb - 1) * 128 + (c >> 3)) * PS + C_SK + h * 64 + (c & 7) * 8);
        pv[i] = *(const u32x4*)(svt + ((size_t)((b * 8 + h) * 64 + (c >> 4))) * 2048 + (kb - 1) * 128 + (c & 15) * 8);
      }
    }
    const bool diag = (kb == qi);
    for (int kt = 3; kt >= 0; --kt) {
      f32x16 s;
#pragma unroll
      for (int i = 0; i < 16; ++i) s[i] = 0.f;
#pragma unroll
      for (int ks = 0; ks < 4; ++ks) { bf16x8 kf = *(const bf16x8*)(Ks + (kt * 32 + r) * 72 + ks * 16 + h2 * 8); s = MFMA32(kf, qf[ks], s); }
      const int keybase = kb * 128 + kt * 32 + 4 * h2;
      float kp[16];
#pragma unroll
      for (int reg = 0; reg < 16; ++reg) {
        kp[reg] = __builtin_amdgcn_rcpf(1.0f + __expf(s[reg]));
        if (diag) { const int key = keybase + (reg & 3) + 8 * (reg >> 2); kp[reg] = (key < qpos) ? kp[reg] : 1.0f; }
      }
      float G[4], Gp[4], off[4];
#pragma unroll
      for (int g = 0; g < 4; ++g) { G[g] = (kp[4 * g] * kp[4 * g + 1]) * (kp[4 * g + 2] * kp[4 * g + 3]); Gp[g] = shx(G[g], 32, lane); }
      const float T0 = G[0] * Gp[0], T1 = G[1] * Gp[1], T2 = G[2] * Gp[2], T3 = G[3] * Gp[3];
      const float st2 = T3, st1 = T3 * T2, st0 = st1 * T1, total = st0 * T0;
      off[3] = carry; off[2] = carry * st2; off[1] = carry * st1; off[0] = carry * st0;
      if (h2 == 0) { off[0] *= Gp[0]; off[1] *= Gp[1]; off[2] *= Gp[2]; off[3] *= Gp[3]; }
      f32x16 w;
#pragma unroll
      for (int g = 0; g < 4; ++g) {
        float e = off[g];
#pragma unroll
        for (int i = 3; i >= 0; --i) {
          const int reg = 4 * g + i;
          w[reg] = (1.0f - kp[reg]) * e;
          e *= kp[reg];
        }
      }
      carry *= total;
#pragma unroll
      for (int sidx = 0; sidx < 2; ++sidx) {
        const bf16x8 pf = pack_frag(w, sidx);
#pragma unroll
        for (int dt = 0; dt < 2; ++dt) {
          const bf16_t* vp = Vt + (dt * 32 + r) * 136 + kt * 32 + 16 * sidx + 4 * h2;
          const s16x4 lo = *(const s16x4*)vp, hi = *(const s16x4*)(vp + 8);
          const bf16x8 vf = __builtin_shufflevector(lo, hi, 0, 1, 2, 3, 4, 5, 6, 7);
          o[dt] = MFMA32(vf, pf, o[dt]);
        }
      }
    }
    { const int alld = __all(carry < 1e-37f); if (lane == 0) ((volatile int*)(smem + 65568))[wave] = alld ? 1 : 0; }
  }
#pragma unroll
  for (int dt = 0; dt < 2; ++dt)
#pragma unroll
    for (int gp = 0; gp < 4; gp += 2) {
      uint2 zq[2], oq[2];
      load32_pair(proj + mq * PS + C_SZ + h * 64 + dt * 32 + 8 * gp, zq[0], zq[1], h2);
#pragma unroll
      for (int q = 0; q < 2; ++q) {
        const int g = gp + q; const uint2 zz = zq[q];
        const float z0 = bf2f((bf16_t)(zz.x & 0xffff)), z1 = bf2f((bf16_t)(zz.x >> 16)), z2 = bf2f((bf16_t)(zz.y & 0xffff)), z3 = bf2f((bf16_t)(zz.y >> 16));
        oq[q].x = pack2(o[dt][4 * g] * siluf_(z0), o[dt][4 * g + 1] * siluf_(z1)); oq[q].y = pack2(o[dt][4 * g + 2] * siluf_(z2), o[dt][4 * g + 3] * siluf_(z3));
      }
      store32_pair(yb + mq * 512 + h * 64 + dt * 32 + 8 * gp, oq[0], oq[1], h2);
    }
}

DI void ret_item(const Params& p, int b, int h, int es, int part, unsigned char* smem) {
  bf16_t* Ks = (bf16_t*)smem;
  bf16_t* Vt = Ks + 64 * 136;
  bf16_t* St = Vt + 64 * 136;
  const bf16_t* proj = (const bf16_t*)(ws_op(p) + OFF_PROJ);
  const bf16_t* rvt = (const bf16_t*)(ws_op(p) + OFF_RVT);
  const bf16_t* kdt = (const bf16_t*)(ws_op(p) + OFF_KDT);
  bf16_t* ya = (bf16_t*)(ws_op(p) + OFF_YA);
  float* ssq = (float*)(ws_op(p) + OFF_SSQ);
  const int tid = tid_op(), lane = tid & 63, wave = tid >> 6, r = lane & 31, h2 = lane >> 5;
  const float lg2 = log2f(1.0f - exp2f(-5.0f - (float)h));
  const float cdec = exp2f(128.0f * lg2);
  const int il = wave * 32 + r;
  const float qdec = exp2f((float)(il + 1) * lg2);
  f32x16 st[2];
#pragma unroll
  for (int i = 0; i < 16; ++i) { st[0][i] = 0.f; st[1][i] = 0.f; }
  const size_t vrow0 = (size_t)((b * 4 + h) * 256 + es * 64);
  const size_t krow = (size_t)((b * 4 + h) * 128 + wave * 32 + r);
  const int srow = tid >> 4, skc = (tid & 15) * 8;
  if (part) {
    for (int n = 0; n < 8; ++n) {
      bf16x8 kdf[8];
#pragma unroll
      for (int ks = 0; ks < 8; ++ks) kdf[ks] = *(const bf16x8*)(kdt + krow * 2048 + n * 128 + ks * 16 + h2 * 8);
      __syncthreads();
#pragma unroll
      for (int i = 0; i < 4; ++i) { const int row = srow + i * 16; *(u32x4*)(Vt + row * 136 + skc) = *(const u32x4*)(rvt + (vrow0 + row) * 2048 + n * 128 + skc); }
      __syncthreads();
#pragma unroll
      for (int i = 0; i < 16; ++i) { st[0][i] *= cdec; st[1][i] *= cdec; }
#pragma unroll
      for (int ks = 0; ks < 8; ++ks)
#pragma unroll
        for (int et = 0; et < 2; ++et) { const bf16x8 vf = *(const bf16x8*)(Vt + (et * 32 + r) * 136 + ks * 16 + h2 * 8); st[et] = MFMA32(vf, kdf[ks], st[et]); }
    }
  }
  for (int n = part * 8; n < part * 8 + 8; ++n) {
    const size_t mq = (size_t)b * 2048 + n * 128 + il;
    bf16x8 qf[8];
#pragma unroll
    for (int ks = 0; ks < 8; ++ks) qf[ks] = *(const bf16x8*)(proj + mq * PS + C_RQ + h * 128 + ks * 16 + h2 * 8);
    __syncthreads();
#pragma unroll
    for (int et = 0; et < 2; ++et)
#pragma unroll
      for (int reg = 0; reg < 16; ++reg) St[(et * 32 + crow(reg, h2)) * 136 + wave * 32 + r] = f2bf(st[et][reg]);
#pragma unroll
    for (int i = 0; i < 4; ++i) {
      const int row = srow + i * 16;
      *(u32x4*)(Vt + row * 136 + skc) = *(const u32x4*)(rvt + (vrow0 + row) * 2048 + n * 128 + skc);
      *(u32x4*)(Ks + row * 136 + skc) = *(const u32x4*)(proj + ((size_t)b * 2048 + n * 128 + row) * PS + C_RK + h * 128 + skc);
    }
    __syncthreads();
    f32x16 o[2];
#pragma unroll
    for (int i = 0; i < 16; ++i) { o[0][i] = 0.f; o[1][i] = 0.f; }
#pragma unroll
    for (int ks = 0; ks < 8; ++ks)
#pragma unroll
      for (int et = 0; et < 2; ++et) { const bf16x8 sf = *(const bf16x8*)(St + (et * 32 + r) * 136 + ks * 16 + h2 * 8); o[et] = MFMA32(sf, qf[ks], o[et]); }
#pragma unroll
    for (int i = 0; i < 16; ++i) { o[0][i] *= qdec; o[1][i] *= qdec; }
    for (int jh = 0; jh < 2; ++jh) {
      if (jh) {
        __syncthreads();
#pragma unroll
        for (int i = 0; i < 4; ++i) {
          const int row = srow + i * 16;
          *(u32x4*)(Ks + row * 136 + skc) = *(const u32x4*)(proj + ((size_t)b * 2048 + n * 128 + 64 + row) * PS + C_RK + h * 128 + skc);
        }
        __syncthreads();
      }
      for (int kt = 0; kt < 2; ++kt) {
        const int key0 = jh * 64 + kt * 32;
        if (key0 > wave * 32 + 31) continue;
        f32x16 s;
#pragma unroll
        for (int i = 0; i < 16; ++i) s[i] = 0.f;
#pragma unroll
        for (int ks = 0; ks < 8; ++ks) { const bf16x8 kf = *(const bf16x8*)(Ks + (kt * 32 + r) * 136 + ks * 16 + h2 * 8); s = MFMA32(kf, qf[ks], s); }
#pragma unroll
        for (int reg = 0; reg < 16; ++reg) {
          const int dl = il - (key0 + crow(reg, h2));
          s[reg] = (dl >= 0) ? s[reg] * __builtin_amdgcn_exp2f((float)dl * lg2) : 0.f;
        }
#pragma unroll
        for (int sidx = 0; sidx < 2; ++sidx) {
          const bf16x8 pf = pack_frag(s, sidx);
#pragma unroll
          for (int et = 0; et < 2; ++et) {
            const bf16_t* vp = Vt + (et * 32 + r) * 136 + key0 + 16 * sidx + 4 * h2;
            const s16x4 lo = *(const s16x4*)vp, hi = *(const s16x4*)(vp + 8);
            const bf16x8 vf = __builtin_shufflevector(lo, hi, 0, 1, 2, 3, 4, 5, 6, 7);
            o[et] = MFMA32(vf, pf, o[et]);
          }
        }
      }
    }
    bf16x8 kdf[8];
#pragma unroll
    for (int ks = 0; ks < 8; ++ks) kdf[ks] = *(const bf16x8*)(kdt + krow * 2048 + n * 128 + ks * 16 + h2 * 8);
    float ss = 0.f;
#pragma unroll
    for (int i = 0; i < 16; ++i) ss += o[0][i] * o[0][i] + o[1][i] * o[1][i];
    ss += shx(ss, 32, lane);
    if (h2 == 0) ssq[mq * 16 + h * 4 + es] = ss;
#pragma unroll
    for (int et = 0; et < 2; ++et)
#pragma unroll
      for (int g = 0; g < 4; g += 2) {
        uint2 oa, ob;
        oa.x = pack2(o[et][4 * g], o[et][4 * g + 1]); oa.y = pack2(o[et][4 * g + 2], o[et][4 * g + 3]);
        ob.x = pack2(o[et][4 * g + 4], o[et][4 * g + 5]); ob.y = pack2(o[et][4 * g + 6], o[et][4 * g + 7]);
        store32_pair(ya + mq * 1024 + h * 256 + es * 64 + et * 32 + 8 * g, oa, ob, h2);
      }
#pragma unroll
    for (int i = 0; i < 16; ++i) { st[0][i] *= cdec; st[1][i] *= cdec; }
#pragma unroll
    for (int ks = 0; ks < 8; ++ks)
#pragma unroll
      for (int et = 0; et < 2; ++et) { const bf16x8 vf = *(const bf16x8*)(Vt + (et * 32 + r) * 136 + ks * 16 + h2 * 8); st[et] = MFMA32(vf, kdf[ks], st[et]); }
  }
}

DI void ret_finalize(const Params& p, int layer) {
  const bf16_t* proj = (const bf16_t*)(ws_op(p) + OFF_PROJ);
  bf16_t* ya = (bf16_t*)(ws_op(p) + OFF_YA);
  const float* ssq = (const float*)(ws_op(p) + OFF_SSQ);
  const float* gn = p.in[5] + layer * 1024;
  const int tid = tid_op();
  for (int idx = (int)blockIdx.x * 256 + tid; idx < TH * 128; idx += gridDim.x * 256) {
    const size_t tok = idx >> 7; const int c8 = (idx & 127) * 8, head = c8 >> 8;
    const float4 s4 = *(const float4*)(ssq + tok * 16 + head * 4);
    const float rstd = rsqrtf((s4.x + s4.y + s4.z + s4.w) * (1.0f / 256.0f) + EPS);
    const u32x4 ov = *(const u32x4*)(ya + tok * 1024 + c8);
    const u32x4 zv = *(const u32x4*)(proj + tok * PS + C_RZ + c8);
    const float4 g0 = *(const float4*)(gn + c8), g1 = *(const float4*)(gn + c8 + 4);
    const float gg[8] = {g0.x, g0.y, g0.z, g0.w, g1.x, g1.y, g1.z, g1.w};
    u32x4 res;
#pragma unroll
    for (int q = 0; q < 4; ++q) {
      const float o0 = bf2f((bf16_t)(ov[q] & 0xffff)), o1 = bf2f((bf16_t)(ov[q] >> 16));
      const float z0 = bf2f((bf16_t)(zv[q] & 0xffff)), z1 = bf2f((bf16_t)(zv[q] >> 16));
      res[q] = pack2(o0 * rstd * gg[2 * q] * siluf_(z0), o1 * rstd * gg[2 * q + 1] * siluf_(z1));
    }
    *(u32x4*)(ya + tok * 1024 + c8) = res;
  }
}

DI void ssm_item(const Params& p, int layer, int b, int g, unsigned char* smem) {
  float* Ss = (float*)smem;
  bf16_t* KTs = (bf16_t*)smem;
  bf16_t* Hp = (bf16_t*)(smem + 33792);
  const bf16_t* proj = (const bf16_t*)(ws_op(p) + OFF_PROJ);
  bf16_t* ycp = (bf16_t*)(ws_op(p) + OFF_YCP);
  const int gi = layer * 32 + g;
  const unsigned char* tb = ws_op(p) + OFF_SSMT + (size_t)gi * SSMT_STRIDE;
  const bf16_t* KTg = (const bf16_t*)(tb + SSMT_KT); const bf16_t* Pg = (const bf16_t*)(tb + SSMT_P); const bf16_t* Qg = (const bf16_t*)(tb + SSMT_Q);
  const float* a32 = (const float*)(tb + SSMT_A32);
  const int tid = tid_op(), lane = tid & 63, wave = tid >> 6, fr = lane & 15, kq = lane >> 4;
  const int chunk = wave * 16 + fr;
  const bf16_t* ubase = proj + ((size_t)b * 2048 + chunk * 32 + (kq >> 1)) * PS + C_CU + g * 16 + 8 * (kq & 1);
  bf16x8 ub[16];
#pragma unroll
  for (int jp = 0; jp < 16; ++jp) ub[jp] = *(const bf16x8*)(ubase + (size_t)(2 * jp) * PS);
  __syncthreads();
#pragma unroll 1
  for (int mt = 0; mt < 8; ++mt) {
    f32x4 acc = {0.f, 0.f, 0.f, 0.f};
    const bf16_t* prow = Pg + (size_t)(mt * 16 + fr) * 512 + kq * 8;
#pragma unroll
    for (int ks = 0; ks < 16; ++ks) { const bf16x8 pf = *(const bf16x8*)(prow + ks * 32); acc = MFMA16(pf, ub[ks], acc); }
    *(f32x4*)(Ss + chunk * 132 + mt * 16 + kq * 4) = acc;
  }
  __syncthreads();
  if (wave == 0) {
    const float ar = a32[lane], ai = a32[64 + lane];
    float hr = 0.f, hi = 0.f;
    for (int c = 0; c < 64; ++c) {
      Hp[c * 136 + lane] = f2bf(hr); Hp[c * 136 + 64 + lane] = f2bf(hi);
      const float sr = Ss[c * 132 + lane], si = Ss[c * 132 + 64 + lane];
      const float nr = ar * hr - ai * hi + sr, ni = ar * hi + ai * hr + si;
      hr = nr; hi = ni;
    }
  }
  __syncthreads();
  for (int c = tid; c < 1056; c += 256) *(u32x4*)(KTs + c * 8) = *(const u32x4*)(KTg + c * 8);
  __syncthreads();
  float dsk[4];
#pragma unroll
  for (int i = 0; i < 4; ++i) dsk[i] = p.in[15][layer * 512 + g * 16 + kq * 4 + i];
  const int th = kq >> 1;
  const bf16_t* ktl = KTs + fr * 16 + 8 * (kq & 1);
#pragma unroll 1
  for (int ih = 0; ih < 2; ++ih) {
    f32x4 acc[16];
#pragma unroll
    for (int ii = 0; ii < 16; ++ii) {
      acc[ii] = f32x4{0.f, 0.f, 0.f, 0.f};
      const bf16_t* qrow = Qg + (size_t)((ih * 16 + ii) * 16 + fr) * 128 + kq * 8;
#pragma unroll
      for (int ks = 0; ks < 4; ++ks) { const bf16x8 qf = *(const bf16x8*)(qrow + ks * 32); const bf16x8 hbk = *(const bf16x8*)(Hp + chunk * 136 + ks * 32 + kq * 8); acc[ii] = MFMA16(qf, hbk, acc[ii]); }
    }
    if (ih == 0) {
#pragma unroll
      for (int ii = 0; ii < 16; ++ii)
#pragma unroll
        for (int jp = 0; jp <= (ii >> 1); ++jp) {
          const int t1 = ii - 2 * jp - th + 1;
          const bf16x8 kf = *(const bf16x8*)(ktl + t1 * 256);
          acc[ii] = MFMA16(kf, ub[jp], acc[ii]);
        }
    } else {
#pragma unroll
      for (int ii = 0; ii < 16; ++ii)
#pragma unroll
        for (int jp = 0; jp <= ((16 + ii) >> 1); ++jp) {
          const int t1 = 16 + ii - 2 * jp - th + 1;
          const bf16x8 kf = *(const bf16x8*)(ktl + t1 * 256);
          acc[ii] = MFMA16(kf, ub[jp], acc[ii]);
        }
    }
#pragma unroll
    for (int ii = 0; ii < 16; ii += 2) {
      const size_t tok = (size_t)b * 2048 + chunk * 32 + ih * 16 + ii;
      uint2 uq[2], oq[2];
      load16_pair(proj + tok * PS + C_CU + g * 16, uq[0], uq[1], kq, PS);
#pragma unroll
      for (int q = 0; q < 2; ++q) {
        const uint2 uu = uq[q];
        const float y0 = gelu_tanh(acc[ii + q][0] + dsk[0] * bf2f((bf16_t)(uu.x & 0xffff)));
        const float y1 = gelu_tanh(acc[ii + q][1] + dsk[1] * bf2f((bf16_t)(uu.x >> 16)));
        const float y2 = gelu_tanh(acc[ii + q][2] + dsk[2] * bf2f((bf16_t)(uu.y & 0xffff)));
        const float y3 = gelu_tanh(acc[ii + q][3] + dsk[3] * bf2f((bf16_t)(uu.y >> 16)));
        oq[q].x = pack2(y0, y1); oq[q].y = pack2(y2, y3);
      }
      store16_pair(ycp + tok * 512 + g * 16, oq[0], oq[1], kq, 512);
    }
  }
}

DI void phase_mixers(const Params& p, int layer, int half, unsigned char* smem) {
  const int NI = 256 + 256 + 1024;
  int* ctr = (int*)(ws_op(p) + OFF_CTR) + (layer * 2 + half);
  int* s_item = (int*)(smem + 65536);
  const int tid = tid_op();
  for (;;) {
    __syncthreads();
    if (tid == 0) *s_item = atomicAdd(ctr, 1);
    __syncthreads();
    const int id = *s_item;
    if (id >= NI) break;
    if (id < 256) ssm_item(p, layer, id >> 5, id & 31, smem);
    else if (id < 512) { const int j = id - 256, q = j & 127; ret_item(p, q >> 4, (q >> 2) & 3, q & 3, 1 - (j >> 7), smem); }
    else { const int j = id - 512, r = j & 63; sb_item(p, r >> 3, r & 7, 15 - (j >> 6), smem); }
  }
}

DI void phase_glu(const Params& p, int layer, unsigned char* smem) {
  const bf16_t* ycp = (const bf16_t*)(ws_op(p) + OFF_YCP);
  const bf16_t* WT = (const bf16_t*)(ws_op(p) + OFF_WT) + (size_t)layer * LAYER_W + W_GLU_T;
  const bf16_t* proj = (const bf16_t*)(ws_op(p) + OFF_PROJ);
  bf16_t* yc = (bf16_t*)(ws_op(p) + OFF_YC);
  const float* bg = p.in[17] + layer * 512;
  const int tid_ = tid_op(), lane = tid_ & 63, wave = tid_ >> 6, wm = wave >> 1, wn = wave & 1;
  for (int t = (int)blockIdx.x; t < 128 * 4; t += gridDim.x) {
    const int m0 = (t >> 2) * 128, n0 = (t & 3) * 128;
    f32x4 acc[4][4]; zero_acc<4>(acc);
    gemm_core<true, 4>(ycp + (size_t)m0 * 512, 512, WT + (size_t)n0 * 512, 512, 512, acc, smem);
#pragma unroll
    for (int i = 0; i < 4; ++i)
#pragma unroll
      for (int jp = 0; jp < 4; jp += 2) {
        const size_t m = m0 + wm * 64 + i * 16 + (lane & 15); const int nb = n0 + wn * 64 + jp * 16;
        uint2 yq[2], zq[2], oq[2];
        load16_pair(ycp + m * 512 + nb, yq[0], yq[1], lane >> 4);
        load16_pair(proj + m * PS + C_CZ + nb, zq[0], zq[1], lane >> 4);
#pragma unroll
        for (int q = 0; q < 2; ++q) {
          const int j = jp + q; const uint2 yy = yq[q], zz = zq[q];
          const float4 b4 = *(const float4*)(bg + nb + q * 16 + (lane >> 4) * 4);
          const float y0 = bf2f((bf16_t)(yy.x & 0xffff)), y1 = bf2f((bf16_t)(yy.x >> 16)), y2 = bf2f((bf16_t)(yy.y & 0xffff)), y3 = bf2f((bf16_t)(yy.y >> 16));
          const float z0 = bf2f((bf16_t)(zz.x & 0xffff)), z1 = bf2f((bf16_t)(zz.x >> 16)), z2 = bf2f((bf16_t)(zz.y & 0xffff)), z3 = bf2f((bf16_t)(zz.y >> 16));
          oq[q].x = pack2(y0 * sigmoidf_(acc[i][j][0] + b4.x) * siluf_(z0), y1 * sigmoidf_(acc[i][j][1] + b4.y) * siluf_(z1));
          oq[q].y = pack2(y2 * sigmoidf_(acc[i][j][2] + b4.z) * siluf_(z2), y3 * sigmoidf_(acc[i][j][3] + b4.w) * siluf_(z3));
        }
        store16_pair(yc + m * 512 + nb, oq[0], oq[1], lane >> 4);
      }
  }
}

DI void phase_merge(const Params& p, int layer, unsigned char* smem) {
  const bf16_t* wl = (const bf16_t*)(ws_op(p) + OFF_WT) + (size_t)layer * LAYER_W;
  const bf16_t* ya = (const bf16_t*)(ws_op(p) + OFF_YA);
  const bf16_t* yb = (const bf16_t*)(ws_op(p) + OFF_YB);
  const bf16_t* yc = (const bf16_t*)(ws_op(p) + OFF_YC);
  const bf16_t* proj = (const bf16_t*)(ws_op(p) + OFF_PROJ);
  bf16_t* merged = (bf16_t*)(ws_op(p) + OFF_H);
  const int tid_ = tid_op(), lane = tid_ & 63, wave = tid_ >> 6, wm = wave >> 1, wn = wave & 1;
  for (int t = (int)blockIdx.x; t < 128 * 8; t += gridDim.x) {
    const int m0 = (t >> 3) * 128, n0 = (t & 7) * 128;
    f32x4 mg[4][4]; zero_acc<4>(mg);
#pragma unroll 1
    for (int br = 0; br < 3; ++br) {
      f32x4 acc[4][4]; zero_acc<4>(acc);
      if (br == 0) gemm_core<true, 4>(ya + (size_t)m0 * 1024, 1024, wl + PA_T + (size_t)n0 * 1024, 1024, 1024, acc, smem);
      else if (br == 1) gemm_core<true, 4>(yb + (size_t)m0 * 512, 512, wl + PB_T + (size_t)n0 * 512, 512, 512, acc, smem);
      else gemm_core<true, 4>(yc + (size_t)m0 * 512, 512, wl + PC_T + (size_t)n0 * 512, 512, 512, acc, smem);
      const int gcol = (br == 0) ? C_GA : (br == 1 ? C_GB : C_GC);
#pragma unroll
      for (int i = 0; i < 4; ++i)
#pragma unroll
        for (int jp = 0; jp < 4; jp += 2) {
          const size_t m = m0 + wm * 64 + i * 16 + (lane & 15);
          uint2 gq[2];
          load16_pair(proj + m * PS + gcol + n0 + wn * 64 + jp * 16, gq[0], gq[1], lane >> 4);
#pragma unroll
          for (int q = 0; q < 2; ++q) {
            const int j = jp + q; const uint2 gg = gq[q];
            mg[i][j][0] += sigmoidf_(bf2f((bf16_t)(gg.x & 0xffff))) * acc[i][j][0];
            mg[i][j][1] += sigmoidf_(bf2f((bf16_t)(gg.x >> 16))) * acc[i][j][1];
            mg[i][j][2] += sigmoidf_(bf2f((bf16_t)(gg.y & 0xffff))) * acc[i][j][2];
            mg[i][j][3] += sigmoidf_(bf2f((bf16_t)(gg.y >> 16))) * acc[i][j][3];
          }
        }
    }
#pragma unroll
    for (int i = 0; i < 4; ++i)
#pragma unroll
      for (int j = 0; j < 4; j += 2) {
        const size_t m = m0 + wm * 64 + i * 16 + (lane & 15);
        uint2 oa, ob;
        oa.x = pack2(mg[i][j][0], mg[i][j][1]); oa.y = pack2(mg[i][j][2], mg[i][j][3]);
        ob.x = pack2(mg[i][j + 1][0], mg[i][j + 1][1]); ob.y = pack2(mg[i][j + 1][2], mg[i][j + 1][3]);
        store16_pair(merged + m * 1024 + n0 + wn * 64 + j * 16, oa, ob, lane >> 4);
      }
  }
}

DI void phase_out(const Params& p, int layer, int half, unsigned char* smem) {
  const bf16_t* wl = (const bf16_t*)(ws_op(p) + OFF_WT) + (size_t)layer * LAYER_W;
  const bf16_t* merged = (const bf16_t*)(ws_op(p) + OFF_H);
  const float* xin = (layer == 0 ? p.in[0] : p.out) + (size_t)half * TH * DM;
  float* xout = p.out + (size_t)half * TH * DM;
  const int tid_ = tid_op(), lane = tid_ & 63, wave = tid_ >> 6, wm = wave >> 1, wn = wave & 1;
  for (int t = (int)blockIdx.x; t < 64 * 8; t += gridDim.x) {
    const int m0 = (t >> 3) * 256, n0 = (t & 7) * 128;
    f32x4 acc[8][4]; zero_acc8(acc);
    gemm_core256<true>(merged + (size_t)m0 * 1024, 1024, wl + WO_T + (size_t)n0 * 1024, 1024, 1024, acc, smem);
#pragma unroll
    for (int i = 0; i < 8; ++i)
#pragma unroll
      for (int j = 0; j < 4; ++j) {
        const size_t m = m0 + wm * 128 + i * 16 + (lane & 15); const int n = n0 + wn * 64 + j * 16 + (lane >> 4) * 4;
        const f32x4 xv = __builtin_nontemporal_load((const f32x4*)(xin + m * DM + n));
        const f32x4 ov = xv + acc[i][j];
        if (layer == 1) __builtin_nontemporal_store(ov, (f32x4*)(xout + m * DM + n));
        else *(f32x4*)(xout + m * DM + n) = ov;
      }
  }
}

#define XB_TMO      128
#define XB_XCNT(j)  (256  + 64 * (j))
#define XB_XSUB(j)  (1280 + 64 * (j))
#define XB_XGEN(j)  (2304 + 64 * (j))
#define XB_TOP      3328
#define XB_TOPGEN   3392
#define XCD_BAR_WORDS 3456
#define XB_SPIN_CAP (1u << 18)
DI unsigned xb_ld(unsigned* p) { return __hip_atomic_load(p, __ATOMIC_RELAXED, __HIP_MEMORY_SCOPE_AGENT); }
DI unsigned xb_add(unsigned* p, unsigned v) { return __hip_atomic_fetch_add(p, v, __ATOMIC_RELAXED, __HIP_MEMORY_SCOPE_AGENT); }
DI unsigned xb_xcc_id() { return (unsigned)__builtin_amdgcn_s_getreg((3 << 11) | 20) & 0xFu; }
#define XB_SPIN(cond, bar) do { unsigned _sp = 0; while (cond) { __builtin_amdgcn_s_sleep(1); \
    if ((++_sp & 255u) == 0u) { if (xb_ld(&(bar)[XB_TMO])) break; if (_sp > XB_SPIN_CAP) { atomicAdd(&(bar)[XB_TMO], 1u); break; } } } } while (0)
struct XcdBarrier { unsigned* bar; unsigned x; volatile unsigned* st; };
DI XcdBarrier xcd_barrier_post(unsigned* bar, volatile unsigned* st) {
  XcdBarrier b; b.bar = bar; b.x = xb_xcc_id(); b.st = st;
  if (threadIdx.x == 0) (void)xb_add(&bar[XB_XCNT(b.x)], 1u);
  return b;
}
DI void xcd_barrier_complete(unsigned* bar, unsigned x, unsigned& nloc, unsigned& nx) {
  const unsigned G = gridDim.x;
  unsigned sum, cnt, mine, sp = 0u;
  for (;;) {
    sum = 0u; cnt = 0u; mine = 0u;
#pragma unroll
    for (unsigned j = 0; j < 16; ++j) { const unsigned c = xb_ld(&bar[XB_XCNT(j)]); sum += c; cnt += (c > 0u) ? 1u : 0u; mine = (j == x) ? c : mine; }
    if (sum == G) break;
    __builtin_amdgcn_s_sleep(1);
    if ((++sp & 255u) == 0u) { if (xb_ld(&bar[XB_TMO])) break; if (sp > XB_SPIN_CAP) { atomicAdd(&bar[XB_TMO], 1u); break; } }
  }
  nloc = mine > 0u ? mine : 1u; nx = cnt > 0u ? cnt : 1u;
}
DI void xcd_barrier(const XcdBarrier& b_unused, const Params& p, unsigned char* smem) {
  XcdBarrier b; b.x = xb_xcc_id(); b.st = (volatile unsigned*)(smem + 65552); b.bar = nullptr;
  asm volatile("s_waitcnt vmcnt(0)" ::: "memory");
  __syncthreads();
  if (threadIdx.x == 0) {
    unsigned* bar = (unsigned*)(ws_op(p) + OFF_BAR);
    __builtin_amdgcn_s_waitcnt(0);
    unsigned nloc = b.st[0], nx = b.st[1];
    if (nloc == 0u) { xcd_barrier_complete(bar, b.x, nloc, nx); b.st[0] = nloc; b.st[1] = nx; }
    const unsigned old = xb_add(&bar[XB_XSUB(b.x)], 1u);
    const unsigned gen = old / nloc;
    if (old + 1u == (gen + 1u) * nloc) {
      __builtin_amdgcn_fence(__ATOMIC_RELEASE, "agent");
      asm volatile("s_waitcnt vmcnt(0)" ::: "memory");
      const unsigned og = xb_add(&bar[XB_TOP], 1u);
      const unsigned tg = og / nx;
      if (og + 1u == (tg + 1u) * nx) xb_add(&bar[XB_TOPGEN], 1u);
      else XB_SPIN(xb_ld(&bar[XB_TOPGEN]) == tg, bar);
      __builtin_amdgcn_fence(__ATOMIC_ACQUIRE, "agent");
      xb_add(&bar[XB_XGEN(b.x)], 1u);
      asm volatile("s_waitcnt vmcnt(0)" ::: "memory");
    } else {
      XB_SPIN(xb_ld(&bar[XB_XGEN(b.x)]) == gen, bar);
      __builtin_amdgcn_fence(__ATOMIC_ACQUIRE, "agent");
      asm volatile("s_waitcnt vmcnt(0)" ::: "memory");
    }
  }
  __syncthreads();
}

__global__ void __launch_bounds__(256, 2) fwd_megakernel(Params p) {
  cg::grid_group grid = cg::this_grid();
  extern __shared__ __attribute__((aligned(1024))) unsigned char smem[];
  volatile unsigned* xst = (volatile unsigned*)(smem + 65552);
  if (threadIdx.x == 0) { xst[0] = 0u; xst[1] = 0u; }
  __syncthreads();
  const XcdBarrier xb = xcd_barrier_post((unsigned*)(ws_op(p) + OFF_BAR), xst);
  phase_prologue(p, smem);
  phase_norm(p, 0, 0);
  if (p.use_cg_sync) grid.sync();
  xcd_barrier(xb, p, smem);
  for (int layer = 0; layer < 2; ++layer)
    for (int half = 0; half < 2; ++half) {
      if (layer | half) { phase_norm(p, layer, half); xcd_barrier(xb, p, smem); }
      phase_inproj(p, layer, smem);
      xcd_barrier(xb, p, smem);
      phase_mixers(p, layer, half, smem);
      xcd_barrier(xb, p, smem);
      phase_glu(p, layer, smem);
      ret_finalize(p, layer);
      xcd_barrier(xb, p, smem);
      phase_merge(p, layer, smem);
      xcd_barrier(xb, p, smem);
      phase_out(p, layer, half, smem);
      xcd_barrier(xb, p, smem);
    }
}

extern "C" void kernel_launch(void* const* d_in, const int* in_sizes, int n_in, void* d_out, int out_size, void* d_ws, size_t ws_size, hipStream_t stream) {
  static int grid_blocks = 0;
  if (grid_blocks == 0) {
    if (n_in != 22 || ws_size < WS_END) { fprintf(stderr, "kernel_launch: unexpected n_in %d or ws_size %zu (need %zu)\n", n_in, ws_size, (size_t)WS_END); grid_blocks = -1; return; }
    int dev = 0, cus = 0, per_cu = 0;
    hipGetDevice(&dev);
    hipDeviceGetAttribute(&cus, hipDeviceAttributeMultiprocessorCount, dev);
    if (hipFuncSetAttribute((const void*)fwd_megakernel, hipFuncAttributeMaxDynamicSharedMemorySize, SMEM_BYTES) != hipSuccess) { fprintf(stderr, "kernel_launch: hipFuncSetAttribute failed\n"); grid_blocks = -1; return; }
    hipOccupancyMaxActiveBlocksPerMultiprocessor(&per_cu, fwd_megakernel, 256, SMEM_BYTES);
    if (per_cu > 2) per_cu = 2;
    if (per_cu < 1) per_cu = 1;
    grid_blocks = cus * per_cu;
  }
  if (grid_blocks < 0) return;
  Params p{};
  for (int i = 0; i < 22; ++i) p.in[i] = (const float*)d_in[i];
  p.out = (float*)d_out; p.ws = (unsigned char*)d_ws; p.use_cg_sync = 0; p.pad_ = 0;
  if (hipMemsetAsync((unsigned char*)d_ws + OFF_CTR, 0, 256 + 3456 * 4, stream) != hipSuccess) { fprintf(stderr, "kernel_launch: memset of control words failed\n"); return; }
  void* args[] = {&p};
  hipError_t e = hipLaunchCooperativeKernel((void*)fwd_megakernel, dim3(grid_blocks), dim3(256), args, SMEM_BYTES, stream);
  if (e != hipSuccess) fprintf(stderr, "cooperative launch failed: %s (grid %d)\n", hipGetErrorString(e), grid_blocks);
}
```

```cpp
#include <hip/hip_runtime.h>
#include <hip/hip_cooperative_groups.h>
#include <cstdio>
#include <cstdint>
namespace cg = cooperative_groups;

typedef unsigned short bf16_t;
typedef short bf16x8 __attribute__((ext_vector_type(8)));
typedef short s16x4 __attribute__((ext_vector_type(4)));
typedef float f32x4 __attribute__((ext_vector_type(4)));
typedef float f32x16 __attribute__((ext_vector_type(16)));
typedef unsigned u32x4 __attribute__((ext_vector_type(4)));
#define DI __device__ __forceinline__
#define MFMA16(a, b, c) __builtin_amdgcn_mfma_f32_16x16x32_bf16((a), (b), (c), 0, 0, 0)
#define MFMA32(a, b, c) __builtin_amdgcn_mfma_f32_32x32x16_bf16((a), (b), (c), 0, 0, 0)

constexpr int DM = 1024, SEQ = 2048, HB = 8, TH = HB * SEQ  , PS = 7680  ;
constexpr float EPS = 1e-6f;
constexpr int C_RQ = 0, C_RK = 512, C_RZ = 1024, C_SQ = 2048, C_SK = 2560, C_SZ = 3072, C_CU = 3584, C_CZ = 4096, C_GA = 4608, C_GB = 5632, C_GC = 6656;
constexpr size_t W_IN_T = 0, W_GLU_T = 9437184, PA_T = 9699328, PB_T = 10747904, PC_T = 11272192, WO_T = 11796480, LAYER_W = 12845056;
constexpr size_t OFF_WT = 0;
constexpr size_t OFF_ROPE = 2 * LAYER_W * 2;
constexpr size_t OFF_H = OFF_ROPE + 2 * 2048 * 64 * 4;
constexpr size_t OFF_PROJ = OFF_H + (size_t)TH * 1024 * 2;
constexpr size_t OFF_RVT = OFF_PROJ + (size_t)TH * PS * 2;
constexpr size_t OFF_SVT = OFF_RVT + (size_t)8 * 4 * 256 * 2048 * 2;
constexpr size_t OFF_YA = OFF_SVT + (size_t)8 * 8 * 64 * 2048 * 2;
constexpr size_t OFF_YB = OFF_YA + (size_t)TH * 1024 * 2;
constexpr size_t OFF_YCP = OFF_YB + (size_t)TH * 512 * 2;
constexpr size_t OFF_YC = OFF_YCP + (size_t)TH * 512 * 2;
constexpr size_t OFF_KDT = OFF_YC + (size_t)TH * 512 * 2;
constexpr size_t OFF_SSQ = OFF_KDT + (size_t)8 * 4 * 128 * 2048 * 2;
constexpr size_t SSMT_KT = 0, SSMT_P = 16896, SSMT_Q = 16896 + 131072, SSMT_A32 = 16896 + 2 * 131072, SSMT_STRIDE = 16896 + 2 * 131072 + 512;
constexpr size_t OFF_SSMT = OFF_SSQ + (size_t)TH * 16 * 4;
constexpr size_t OFF_CTR = OFF_SSMT + 64 * SSMT_STRIDE;
constexpr size_t OFF_BAR = OFF_CTR + 256;
constexpr size_t WS_END = OFF_BAR + 3456 * 4;
static_assert(WS_END <= 536870912, "workspace map exceeds 4x the largest tensor");

constexpr int SMEM_BYTES = 67584;

struct Params { const float* in[22]; float* out; unsigned char* ws; int use_cg_sync; int pad_; };

DI unsigned char* ws_op(const Params& p) { size_t z = 0; asm volatile("" : "+s"(z)); return p.ws + z; }
DI float shx(float v, int k, int lane) { return __builtin_bit_cast(float, __builtin_amdgcn_ds_bpermute((lane ^ k) << 2, __builtin_bit_cast(int, v))); }
DI float bf2f(bf16_t v) { return __uint_as_float(((unsigned)v) << 16); }
DI bf16_t f2bf(float x) { unsigned u = __float_as_uint(x); u += 0x7fffu + ((u >> 16) & 1u); return (bf16_t)(u >> 16); }
DI unsigned pack2(float lo, float hi) { unsigned r; asm volatile("v_cvt_pk_bf16_f32 %0, %1, %2" : "=v"(r) : "v"(lo), "v"(hi)); return r; }
DI float sigmoidf_(float x) { return __builtin_amdgcn_rcpf(1.0f + __expf(-x)); }
DI float siluf_(float x) { return x * sigmoidf_(x); }
DI float gelu_tanh(float y) { float a = 0.7978845608028654f * (y + 0.044715f * y * y * y); float t = 1.0f - 2.0f * __builtin_amdgcn_rcpf(__expf(2.0f * a) + 1.0f); return 0.5f * y * (1.0f + t); }
DI void swap16(unsigned& a, unsigned& b) { asm volatile("v_nop\n\tv_nop\n\tv_permlane16_swap_b32 %0, %1" : "+v"(a), "+v"(b)); }
DI void store16_pair(bf16_t* rowp, uint2 a, uint2 b, int kq, int odd_off = 16) {
  swap16(a.x, b.x); swap16(a.y, b.y);
  *(u32x4*)(rowp + (kq & 1) * odd_off + (kq >> 1) * 8) = u32x4{a.x, a.y, b.x, b.y};
}
DI void store16_pair_nt(bf16_t* rowp, uint2 a, uint2 b, int kq, int odd_off = 16) {
  swap16(a.x, b.x); swap16(a.y, b.y);
  __builtin_nontemporal_store(u32x4{a.x, a.y, b.x, b.y}, (u32x4*)(rowp + (kq & 1) * odd_off + (kq >> 1) * 8));
}
DI void load16_pair(const bf16_t* rowp, uint2& a, uint2& b, int kq, int odd_off = 16) {
  const u32x4 v = *(const u32x4*)(rowp + (kq & 1) * odd_off + (kq >> 1) * 8);
  a.x = v[0]; a.y = v[1]; b.x = v[2]; b.y = v[3];
  swap16(a.x, b.x); swap16(a.y, b.y);
}
DI void swap32(unsigned& a, unsigned& b) { asm volatile("v_nop\n\tv_nop\n\tv_permlane32_swap_b32 %0, %1" : "+v"(a), "+v"(b)); }
DI void store32_pair(bf16_t* p8  , uint2 a, uint2 b, int h2) {
  swap32(a.x, b.x); swap32(a.y, b.y);
  *(u32x4*)(p8 + h2 * 8) = u32x4{a.x, a.y, b.x, b.y};
}
DI void load32_pair(const bf16_t* p8, uint2& a, uint2& b, int h2) {
  const u32x4 v = *(const u32x4*)(p8 + h2 * 8);
  a.x = v[0]; a.y = v[1]; b.x = v[2]; b.y = v[3];
  swap32(a.x, b.x); swap32(a.y, b.y);
}
DI int crow(int reg, int h2) { return (reg & 3) + 8 * (reg >> 2) + 4 * h2; }
DI int tid_op() { int t = threadIdx.x; asm volatile("" : "+v"(t)); return t; }
struct Params;
DI unsigned char* ws_op(const Params& p);

constexpr int BK = 64;
DI int lds_byte2(int r, int c) { const int st = (r >> 4) * 2 + (c >> 5), ob = (r & 15) * 64 + (c & 31) * 2; return st * 1024 + (ob ^ (((ob >> 9) & 1) << 5)); }
DI void stage_rc2(int b, int& R, int& C) { const int st = b >> 10, sb = b & 1023, swz = sb ^ (((sb >> 9) & 1) << 5); R = (st >> 1) * 16 + (swz >> 6); C = (st & 1) * 32 + ((swz & 63) >> 1); }
#define WAIT_VM0() asm volatile("s_waitcnt vmcnt(0)" ::: "memory")
template <bool SWAP, int NJ>
DI void gemm_core(const bf16_t* __restrict__ A, int lda, const bf16_t* __restrict__ Bt, int ldb, int K, f32x4 (&acc)[4][NJ], unsigned char* sm, bool pre = false) {
  const int tid = tid_op(), lane = tid & 63, wid = tid >> 6, wm = wid >> 1, wn = wid & 1, fr = lane & 15, fq = lane >> 4;
  int aoff[4], boff[NJ];
#pragma unroll
  for (int i = 0; i < 4; ++i) { int R, C; stage_rc2(wid * 1024 + i * 4096 + lane * 16, R, C); aoff[i] = R * lda + C; }
#pragma unroll
  for (int i = 0; i < NJ; ++i) { int R, C; stage_rc2(wid * 1024 + i * 4096 + lane * 16, R, C); boff[i] = R * ldb + C; }
  const int lo = (fr * 64 + fq * 16) ^ ((fr >> 3) << 5);
  const int nt = K / BK;
  if (!pre) {
    __syncthreads();
#pragma unroll
    for (int i = 0; i < 4; ++i) __builtin_amdgcn_global_load_lds((const unsigned*)(A + aoff[i]), (__attribute__((address_space(3))) unsigned*)(sm + wid * 1024 + i * 4096), 16, 0, 0);
#pragma unroll
    for (int i = 0; i < NJ; ++i) __builtin_amdgcn_global_load_lds((const unsigned*)(Bt + boff[i]), (__attribute__((address_space(3))) unsigned*)(sm + 16384 + wid * 1024 + i * 4096), 16, 0, 0);
  }
  WAIT_VM0();
  __syncthreads();
  for (int t = 0; t < nt; ++t) {
    unsigned char* cur = sm + (t & 1) * 32768;
    unsigned char* nxt = sm + ((t & 1) ^ 1) * 32768;
    if (t + 1 < nt) {
      const int ko = (t + 1) * BK;
#pragma unroll
      for (int i = 0; i < 4; ++i) __builtin_amdgcn_global_load_lds((const unsigned*)(A + aoff[i] + ko), (__attribute__((address_space(3))) unsigned*)(nxt + wid * 1024 + i * 4096), 16, 0, 0);
#pragma unroll
      for (int i = 0; i < NJ; ++i) __builtin_amdgcn_global_load_lds((const unsigned*)(Bt + boff[i] + ko), (__attribute__((address_space(3))) unsigned*)(nxt + 16384 + wid * 1024 + i * 4096), 16, 0, 0);
    }
    bf16x8 af[2][4], bfr[2][NJ];
#pragma unroll
    for (int ks = 0; ks < 2; ++ks) {
#pragma unroll
      for (int i = 0; i < 4; ++i) af[ks][i] = *(const bf16x8*)(cur + ((wm * 4 + i) * 2 + ks) * 1024 + lo);
#pragma unroll
      for (int j = 0; j < NJ; ++j) bfr[ks][j] = *(const bf16x8*)(cur + 16384 + ((wn * NJ + j) * 2 + ks) * 1024 + lo);
      __builtin_amdgcn_sched_barrier(0);
    }
#pragma unroll
    for (int ks = 0; ks < 2; ++ks) {
#pragma unroll
      for (int i = 0; i < 4; ++i)
#pragma unroll
        for (int j = 0; j < NJ; ++j) acc[i][j] = SWAP ? MFMA16(bfr[ks][j], af[ks][i], acc[i][j]) : MFMA16(af[ks][i], bfr[ks][j], acc[i][j]);
      __builtin_amdgcn_sched_barrier(0);
    }
    WAIT_VM0();
    __syncthreads();
  }
}

DI void gemm_issue0(const bf16_t* __restrict__ A, int lda, const bf16_t* __restrict__ Bt, int ldb, unsigned char* sm) {
  const int tid = tid_op(), lane = tid & 63, wid = tid >> 6;
#pragma unroll
  for (int i = 0; i < 4; ++i) {
    int R, C; stage_rc2(wid * 1024 + i * 4096 + lane * 16, R, C);
    __builtin_amdgcn_global_load_lds((const unsigned*)(A + R * lda + C), (__attribute__((address_space(3))) unsigned*)(sm + wid * 1024 + i * 4096), 16, 0, 0);
    __builtin_amdgcn_global_load_lds((const unsigned*)(Bt + R * ldb + C), (__attribute__((address_space(3))) unsigned*)(sm + 16384 + wid * 1024 + i * 4096), 16, 0, 0);
  }
}
template <bool SWAP>
DI void gemm_core256(const bf16_t* __restrict__ A, int lda, const bf16_t* __restrict__ Bt, int ldb, int K, f32x4 (&acc)[8][4], unsigned char* sm) {
  const int tid = tid_op(), lane = tid & 63, wid = tid >> 6, wm = wid >> 1, wn = wid & 1, fr = lane & 15, fq = lane >> 4;
  int aoff[4], boff[2];
#pragma unroll
  for (int i = 0; i < 4; ++i) { const int b = wid * 1024 + i * 4096 + lane * 16, R = b >> 6, c = ((b >> 4) & 3) ^ ((-(R >> 2)) & 3); aoff[i] = R * lda + c * 8; }
#pragma unroll
  for (int i = 0; i < 2; ++i) { const int b = wid * 1024 + i * 4096 + lane * 16, R = b >> 6, c = ((b >> 4) & 3) ^ ((-(R >> 2)) & 3); boff[i] = R * ldb + c * 8; }
  const int lo = fr * 64 + ((fq ^ ((-(fr >> 2)) & 3)) << 4);
  const int nt = K / 32;
  __syncthreads();
#pragma unroll
  for (int i = 0; i < 4; ++i) __builtin_amdgcn_global_load_lds((const unsigned*)(A + aoff[i]), (__attribute__((address_space(3))) unsigned*)(sm + wid * 1024 + i * 4096), 16, 0, 0);
#pragma unroll
  for (int i = 0; i < 2; ++i) __builtin_amdgcn_global_load_lds((const unsigned*)(Bt + boff[i]), (__attribute__((address_space(3))) unsigned*)(sm + 16384 + wid * 1024 + i * 4096), 16, 0, 0);
  WAIT_VM0();
  __syncthreads();
  for (int t = 0; t < nt; ++t) {
    unsigned char* cur = sm + (t & 1) * 24576;
    unsigned char* nxt = sm + ((t & 1) ^ 1) * 24576;
    if (t + 1 < nt) {
      const int ko = (t + 1) * 32;
#pragma unroll
      for (int i = 0; i < 4; ++i) __builtin_amdgcn_global_load_lds((const unsigned*)(A + aoff[i] + ko), (__attribute__((address_space(3))) unsigned*)(nxt + wid * 1024 + i * 4096), 16, 0, 0);
#pragma unroll
      for (int i = 0; i < 2; ++i) __builtin_amdgcn_global_load_lds((const unsigned*)(Bt + boff[i] + ko), (__attribute__((address_space(3))) unsigned*)(nxt + 16384 + wid * 1024 + i * 4096), 16, 0, 0);
    }
    bf16x8 af[8], bfr[4];
#pragma unroll
    for (int i = 0; i < 8; ++i) af[i] = *(const bf16x8*)(cur + (wm * 8 + i) * 1024 + lo);
#pragma unroll
    for (int j = 0; j < 4; ++j) bfr[j] = *(const bf16x8*)(cur + 16384 + (wn * 4 + j) * 1024 + lo);
    __builtin_amdgcn_sched_barrier(0);
#pragma unroll
    for (int i = 0; i < 8; ++i)
#pragma unroll
      for (int j = 0; j < 4; ++j) acc[i][j] = SWAP ? MFMA16(bfr[j], af[i], acc[i][j]) : MFMA16(af[i], bfr[j], acc[i][j]);
    __builtin_amdgcn_sched_barrier(0);
    WAIT_VM0();
    __syncthreads();
  }
}
DI void zero_acc8(f32x4 (&acc)[8][4]) {
#pragma unroll
  for (int i = 0; i < 8; ++i)
#pragma unroll
    for (int j = 0; j < 4; ++j) acc[i][j] = f32x4{0.f, 0.f, 0.f, 0.f};
}
template <int NJ>
DI void zero_acc(f32x4 (&acc)[4][NJ]) {
#pragma unroll
  for (int i = 0; i < 4; ++i)
#pragma unroll
    for (int j = 0; j < NJ; ++j) acc[i][j] = f32x4{0.f, 0.f, 0.f, 0.f};
}

DI void transpose_tile(const float* __restrict__ W, int K, int N, bf16_t* __restrict__ WT, int tile, float* sm) {
  const int tid = tid_op();
  const int ntn = N >> 6, kt = tile / ntn, nt = tile % ntn;
  __syncthreads();
#pragma unroll
  for (int i = 0; i < 4; ++i) {
    int idx = tid + i * 256, row = idx >> 4, c4 = (idx & 15) * 4;
    float4 v = *(const float4*)(W + (size_t)(kt * 64 + row) * N + nt * 64 + c4);
    sm[row * 65 + c4 + 0] = v.x; sm[row * 65 + c4 + 1] = v.y; sm[row * 65 + c4 + 2] = v.z; sm[row * 65 + c4 + 3] = v.w;
  }
  __syncthreads();
  const int n = tid >> 2, kq = (tid & 3) * 16;
  unsigned pk[8];
#pragma unroll
  for (int i = 0; i < 8; ++i) pk[i] = pack2(sm[(kq + 2 * i) * 65 + n], sm[(kq + 2 * i + 1) * 65 + n]);
  uint4* dst = (uint4*)(WT + (size_t)(nt * 64 + n) * K + kt * 64 + kq);
  dst[0] = uint4{pk[0], pk[1], pk[2], pk[3]};
  dst[1] = uint4{pk[4], pk[5], pk[6], pk[7]};
}

DI void ssm_tables(const Params& p, int layer, int g, float* sm, int part, int nparts) {
  float* pwr = sm; float* pwi = pwr + 33 * 64; float* bbr = pwi + 33 * 64; float* bbi = bbr + 1024; float* cr = bbi + 1024; float* ci = cr + 1024;
  const int tid = tid_op(), gi = layer * 32 + g;
  unsigned char* tb = ws_op(p) + OFF_SSMT + (size_t)gi * SSMT_STRIDE;
  __syncthreads();
  if (tid < 64) {
    const float a_re = p.in[8][gi * 64 + tid], a_im = p.in[9][gi * 64 + tid];
    const float dt = expf(p.in[10][gi]);
    const float mag = expf(dt * a_re);
    const float abr = mag * cosf(dt * a_im), abi = mag * sinf(dt * a_im);
    const float den = a_re * a_re + a_im * a_im, nr = abr - 1.0f;
    const float cfr = (nr * a_re + abi * a_im) / den, cfi = (abi * a_re - nr * a_im) / den;
    const float* bre = p.in[11] + ((size_t)gi * 64 + tid) * 16;
    const float* bim = p.in[12] + ((size_t)gi * 64 + tid) * 16;
    for (int m = 0; m < 16; ++m) { const float br = bre[m], bi = bim[m]; bbr[tid * 16 + m] = cfr * br - cfi * bi; bbi[tid * 16 + m] = cfr * bi + cfi * br; }
    float pr = 1.0f, pi = 0.0f;
    for (int t = 0; t <= 32; ++t) { pwr[t * 64 + tid] = pr; pwi[t * 64 + tid] = pi; const float nr2 = pr * abr - pi * abi, ni2 = pr * abi + pi * abr; pr = nr2; pi = ni2; }
    float* a32 = (float*)(tb + SSMT_A32);
    if (part == 0) { a32[tid] = pwr[32 * 64 + tid]; a32[64 + tid] = pwi[32 * 64 + tid]; }
  }
  for (int idx = tid; idx < 1024; idx += 256) { cr[idx] = p.in[13][(size_t)gi * 1024 + idx]; ci[idx] = p.in[14][(size_t)gi * 1024 + idx]; }
  __syncthreads();
  bf16_t* KT = (bf16_t*)(tb + SSMT_KT); bf16_t* P = (bf16_t*)(tb + SSMT_P); bf16_t* Q = (bf16_t*)(tb + SSMT_Q);
  for (int idx = tid + part * 256; idx < 33 * 256; idx += 256 * nparts) {
    const int t1 = idx >> 8, m = (idx >> 4) & 15, mp = idx & 15;
    float acc = 0.f;
    if (t1 > 0) {
      const int t = t1 - 1;
      for (int q = 0; q < 64; ++q) {
        const float ar = pwr[t * 64 + q], ai = pwi[t * 64 + q], br = bbr[q * 16 + mp], bi = bbi[q * 16 + mp];
        acc += cr[m * 64 + q] * (ar * br - ai * bi) - ci[m * 64 + q] * (ar * bi + ai * br);
      }
    }
    KT[idx] = f2bf(acc);
  }
  for (int idx = tid + part * 256; idx < 128 * 512; idx += 256 * nparts) {
    const int pp = idx >> 9, k = idx & 511, j = k >> 4, mp = k & 15, q = pp & 63, e = 31 - j;
    const float ar = pwr[e * 64 + q], ai = pwi[e * 64 + q], br = bbr[q * 16 + mp], bi = bbi[q * 16 + mp];
    P[idx] = f2bf(pp < 64 ? (ar * br - ai * bi) : (ar * bi + ai * br));
  }
  for (int idx = tid + part * 256; idx < 512 * 128; idx += 256 * nparts) {
    const int row = idx >> 7, pp = idx & 127, i = row >> 4, m = row & 15, q = pp & 63;
    const float ar = pwr[(i + 1) * 64 + q], ai = pwi[(i + 1) * 64 + q], c_r = cr[m * 64 + q], c_i = ci[m * 64 + q];
    Q[idx] = f2bf(pp < 64 ? (c_r * ar - c_i * ai) : (-c_r * ai - c_i * ar));
  }
}

struct TrTask { const float* W; bf16_t* WT; int K, N, tile; };
DI TrTask tr_resolve(const Params& p, int u) {
  const int layer = u / 3136, r = u % 3136;
  bf16_t* wl = (bf16_t*)(ws_op(p) + OFF_WT) + (size_t)layer * LAYER_W;
  TrTask t;
  if (r < 2304) { t.W = p.in[2] + (size_t)layer * 1024 * 9216; t.K = 1024; t.N = 9216; t.WT = wl + W_IN_T; t.tile = r; }
  else if (r < 2368) { t.W = p.in[16] + (size_t)layer * 512 * 512; t.K = 512; t.N = 512; t.WT = wl + W_GLU_T; t.tile = r - 2304; }
  else if (r < 2624) { t.W = p.in[18] + (size_t)layer * 1024 * 1024; t.K = 1024; t.N = 1024; t.WT = wl + PA_T; t.tile = r - 2368; }
  else if (r < 2752) { t.W = p.in[19] + (size_t)layer * 512 * 1024; t.K = 512; t.N = 1024; t.WT = wl + PB_T; t.tile = r - 2624; }
  else if (r < 2880) { t.W = p.in[20] + (size_t)layer * 512 * 1024; t.K = 512; t.N = 1024; t.WT = wl + PC_T; t.tile = r - 2752; }
  else { t.W = p.in[21] + (size_t)layer * 1024 * 1024; t.K = 1024; t.N = 1024; t.WT = wl + WO_T; t.tile = r - 2880; }
  return t;
}
DI void tr_load(const TrTask& t, int tid, f32x4 (&v)[4]) {
  const int ntn = t.N >> 6, kt = t.tile / ntn, nt = t.tile % ntn;
#pragma unroll
  for (int i = 0; i < 4; ++i) { const int idx = tid + i * 256, row = idx >> 4, c4 = (idx & 15) * 4; v[i] = __builtin_nontemporal_load((const f32x4*)(t.W + (size_t)(kt * 64 + row) * t.N + nt * 64 + c4)); }
}
DI void tr_finish(const TrTask& t, int tid, const f32x4 (&v)[4], float* sm) {
  const int ntn = t.N >> 6, kt = t.tile / ntn, nt = t.tile % ntn;
  __syncthreads();
#pragma unroll
  for (int i = 0; i < 4; ++i) { const int idx = tid + i * 256, row = idx >> 4, c4 = (idx & 15) * 4; sm[row * 65 + c4 + 0] = v[i][0]; sm[row * 65 + c4 + 1] = v[i][1]; sm[row * 65 + c4 + 2] = v[i][2]; sm[row * 65 + c4 + 3] = v[i][3]; }
  __syncthreads();
  const int n = tid >> 2, kq = (tid & 3) * 16;
  u32x4 lo, hi;
#pragma unroll
  for (int i = 0; i < 4; ++i) { lo[i] = pack2(sm[(kq + 2 * i) * 65 + n], sm[(kq + 2 * i + 1) * 65 + n]); hi[i] = pack2(sm[(kq + 8 + 2 * i) * 65 + n], sm[(kq + 9 + 2 * i) * 65 + n]); }
  u32x4* dst = (u32x4*)(t.WT + (size_t)(nt * 64 + n) * t.K + kt * 64 + kq);
  dst[0] = lo; dst[1] = hi;
}

DI void phase_prologue(const Params& p, unsigned char* smem) {
  float* sm = (float*)smem;
  const int tid = tid_op();
  const int G = (int)gridDim.x, bid = (int)blockIdx.x;
  for (int q = bid; q < 256; q += G) ssm_tables(p, q >> 7, (q >> 2) & 31, sm, q & 3, 4);
  {
    int u = bid;
    f32x4 cur[4], nxt[4];
    if (u < 2 * 3136) { const TrTask t0 = tr_resolve(p, u); tr_load(t0, tid, cur); }
    for (; u < 2 * 3136; u += G) {
      const int un = u + G;
      if (un < 2 * 3136) { const TrTask tn = tr_resolve(p, un); tr_load(tn, tid, nxt); }
      const TrTask t = tr_resolve(p, u);
      tr_finish(t, tid, cur, sm);
#pragma unroll
      for (int i = 0; i < 4; ++i) cur[i] = nxt[i];
    }
  }
  for (int r = bid; r < 512; r += G) {
    const int idx = r * 256 + tid;
    const int pos = idx >> 6, i = idx & 63;
    const float inv = exp2f(-(float)i * (13.287712379549449f / 64.0f));
    const float ang = (float)pos * inv;
    float* cosT = (float*)(ws_op(p) + OFF_ROPE); float* sinT = cosT + 2048 * 64;
    cosT[idx] = cosf(ang); sinT[idx] = sinf(ang);
  }
}

DI void phase_norm(const Params& p, int layer, int half) {
  const float* xin = (layer == 0 ? p.in[0] : p.out) + (size_t)half * TH * DM;
  const float* g = p.in[1] + layer * DM;
  bf16_t* h = (bf16_t*)(ws_op(p) + OFF_H);
  const int tid_ = tid_op(), lane = tid_ & 63, wave = tid_ >> 6;
  const int rstride = (int)gridDim.x * 4;
  for (int row = (int)blockIdx.x * 4 + wave; row < TH; row += rstride * 2) {
    const int row2 = row + rstride; const bool has2 = row2 < TH;
    const float* xa = xin + (size_t)row * DM; const float* xb = xin + (size_t)(has2 ? row2 : row) * DM;
    f32x4 va[4], vb[4]; float sa = 0.f, sb = 0.f;
#pragma unroll
    for (int i = 0; i < 4; ++i) { va[i] = *(const f32x4*)(xa + i * 256 + lane * 4); vb[i] = *(const f32x4*)(xb + i * 256 + lane * 4); }
#pragma unroll
    for (int i = 0; i < 4; ++i) {
      sa += va[i][0] * va[i][0] + va[i][1] * va[i][1] + va[i][2] * va[i][2] + va[i][3] * va[i][3];
      sb += vb[i][0] * vb[i][0] + vb[i][1] * vb[i][1] + vb[i][2] * vb[i][2] + vb[i][3] * vb[i][3];
    }
#pragma unroll
    for (int o = 32; o >= 1; o >>= 1) { sa += shx(sa, o, lane); sb += shx(sb, o, lane); }
    const float ra = rsqrtf(sa * (1.0f / 1024.0f) + EPS), rb = rsqrtf(sb * (1.0f / 1024.0f) + EPS);
#pragma unroll
    for (int i = 0; i < 4; ++i) {
      const f32x4 g4 = *(const f32x4*)(g + i * 256 + lane * 4);
      uint2 o2; o2.x = pack2(va[i][0] * ra * g4[0], va[i][1] * ra * g4[1]); o2.y = pack2(va[i][2] * ra * g4[2], va[i][3] * ra * g4[3]);
      *(uint2*)(h + (size_t)row * DM + i * 256 + lane * 4) = o2;
      if (has2) {
        uint2 o3; o3.x = pack2(vb[i][0] * rb * g4[0], vb[i][1] * rb * g4[1]); o3.y = pack2(vb[i][2] * rb * g4[2], vb[i][3] * rb * g4[3]);
        *(uint2*)(h + (size_t)row2 * DM + i * 256 + lane * 4) = o3;
      }
    }
  }
}

DI void phase_inproj(const Params& p, int layer, unsigned char* smem) {
  const bf16_t* h = (const bf16_t*)(ws_op(p) + OFF_H);
  const bf16_t* WinT = (const bf16_t*)(ws_op(p) + OFF_WT) + (size_t)layer * LAYER_W + W_IN_T;
  bf16_t* proj = (bf16_t*)(ws_op(p) + OFF_PROJ);
  bf16_t* rvt = (bf16_t*)(ws_op(p) + OFF_RVT);
  bf16_t* svt = (bf16_t*)(ws_op(p) + OFF_SVT);
  const int tid_ = tid_op(), lane = tid_ & 63, wave = tid_ >> 6, wm = wave >> 1, wn = wave & 1;
  bool pre = false;
  for (int t = (int)blockIdx.x; t < 128 * 72; t += gridDim.x) {
    const int mt = t / 72, nt = t % 72, m0 = mt * 128, n0 = nt * 128;
    f32x4 acc[4][4]; zero_acc<4>(acc);
    const bool isrv = (n0 >= 1024 && n0 < 2048), issv = (n0 >= 4096 && n0 < 4608);
    const int tn = t + (int)gridDim.x;
    const bool chain = (tn < 128 * 72) && (isrv || issv || n0 >= 1024);
    const bf16_t* An = h + (size_t)((tn / 72) * 128) * DM; const bf16_t* Bn = WinT + (size_t)((tn % 72) * 128) * DM;
    if (isrv || issv) {
      gemm_core<false, 4>(h + (size_t)m0 * DM, DM, WinT + (size_t)n0 * DM, DM, DM, acc, smem, pre);
      pre = chain;
      if (chain) gemm_issue0(An, DM, Bn, DM, smem);
#pragma unroll
      for (int i = 0; i < 4; i += 2)
#pragma unroll
        for (int j = 0; j < 4; ++j) {
          const int mb = m0 + wm * 64 + i * 16, n = n0 + wn * 64 + j * 16 + (lane & 15);
          const int bl = mb >> 11, s = mb & 2047;
          uint2 oa, ob;
          oa.x = pack2(acc[i][j][0], acc[i][j][1]); oa.y = pack2(acc[i][j][2], acc[i][j][3]);
          ob.x = pack2(acc[i + 1][j][0], acc[i + 1][j][1]); ob.y = pack2(acc[i + 1][j][2], acc[i + 1][j][3]);
          bf16_t* rowp;
          if (isrv) { const int c = n - 1024, hh = c >> 8, dv = c & 255; rowp = rvt + ((size_t)((bl * 4 + hh) * 256 + dv)) * 2048 + s; }
          else { const int c = n - 4096, hh = c >> 6, dv = c & 63; rowp = svt + ((size_t)((bl * 8 + hh) * 64 + dv)) * 2048 + s; }
          store16_pair_nt(rowp, oa, ob, lane >> 4);
        }
    } else {
      gemm_core<true, 4>(h + (size_t)m0 * DM, DM, WinT + (size_t)n0 * DM, DM, DM, acc, smem, pre);
      pre = chain;
      if (chain) gemm_issue0(An, DM, Bn, DM, smem);
      const int shift = (n0 >= 2048 ? 1024 : 0) + (n0 >= 4608 ? 512 : 0);
      const int fr = lane & 15, kq = lane >> 4;
      if (n0 >= 3072 && n0 < 4096) {
        const bool isq = n0 < 3584;
        const float* gain = (isq ? p.in[6] : p.in[7]) + layer * 64;
#pragma unroll
        for (int i = 0; i < 4; ++i) {
          float ss = 0.f;
#pragma unroll
          for (int j = 0; j < 4; ++j) ss += acc[i][j][0] * acc[i][j][0] + acc[i][j][1] * acc[i][j][1] + acc[i][j][2] * acc[i][j][2] + acc[i][j][3] * acc[i][j][3];
          ss += shx(ss, 16, lane); ss += shx(ss, 32, lane);
          const float rs = rsqrtf(ss * (1.0f / 64.0f) + EPS) * (isq ? 0.125f : 1.0f);
#pragma unroll
          for (int j = 0; j < 4; ++j) { const float4 g4 = *(const float4*)(gain + j * 16 + kq * 4); acc[i][j][0] *= rs * g4.x; acc[i][j][1] *= rs * g4.y; acc[i][j][2] *= rs * g4.z; acc[i][j][3] *= rs * g4.w; }
        }
      } else if (n0 < 1024) {
        const bool isq = n0 < 512;
        const int hk = (n0 & 511) >> 7;
        const float* gain = (isq ? p.in[3] : p.in[4]) + layer * 128 + wn * 64;
        float* xv = (float*)smem;
        float* ssx = (float*)(smem + 65600);
        const float* cosT = (const float*)(ws_op(p) + OFF_ROPE); const float* sinT = cosT + 2048 * 64;
        float ssp[4];
#pragma unroll
        for (int i = 0; i < 4; ++i) {
          float ss = 0.f;
#pragma unroll
          for (int j = 0; j < 4; ++j) ss += acc[i][j][0] * acc[i][j][0] + acc[i][j][1] * acc[i][j][1] + acc[i][j][2] * acc[i][j][2] + acc[i][j][3] * acc[i][j][3];
          ss += shx(ss, 16, lane); ss += shx(ss, 32, lane);
          ssp[i] = ss;
          if (kq == 0) ssx[wave * 64 + i * 16 + fr] = ss;
        }
        __syncthreads();
#pragma unroll
        for (int i = 0; i < 4; ++i) {
          const float rs = rsqrtf((ssp[i] + ssx[(wave ^ 1) * 64 + i * 16 + fr]) * (1.0f / 128.0f) + EPS);
#pragma unroll
          for (int j = 0; j < 4; ++j) {
            const float4 g4 = *(const float4*)(gain + j * 16 + kq * 4);
            acc[i][j][0] *= rs * g4.x; acc[i][j][1] *= rs * g4.y; acc[i][j][2] *= rs * g4.z; acc[i][j][3] *= rs * g4.w;
#pragma unroll
            for (int r = 0; r < 4; ++r) xv[wave * 4096 + ((i * 4 + j) * 4 + r) * 64 + lane] = acc[i][j][r];
          }
        }
        __syncthreads();
        const float sgn = wn ? 1.0f : -1.0f, ksc = isq ? 1.0f : 0.08838834764831845f;
        const float lg2k = log2f(1.0f - exp2f(-5.0f - (float)hk));
#pragma unroll
        for (int i = 0; i < 4; ++i) {
          const int m = m0 + wm * 64 + i * 16 + fr, pos = m & 2047;
          const float kd = exp2f((float)(127 - (pos & 127)) * lg2k);
          bf16_t* kdst = (bf16_t*)(ws_op(p) + OFF_KDT) + ((size_t)(((m >> 11) * 4 + hk) * 128 + wn * 64)) * 2048 + pos;
#pragma unroll
          for (int j = 0; j < 4; ++j) {
            const float4 c4 = *(const float4*)(cosT + pos * 64 + j * 16 + kq * 4), s4 = *(const float4*)(sinT + pos * 64 + j * 16 + kq * 4);
            const float cc[4] = {c4.x, c4.y, c4.z, c4.w}, sn[4] = {s4.x, s4.y, s4.z, s4.w};
#pragma unroll
            for (int r = 0; r < 4; ++r) {
              const float other = xv[(wave ^ 1) * 4096 + ((i * 4 + j) * 4 + r) * 64 + lane];
              const float o = (acc[i][j][r] * cc[r] + sgn * other * sn[r]) * ksc;
              acc[i][j][r] = o;
              if (!isq) kdst[(size_t)(j * 16 + kq * 4 + r) * 2048] = f2bf(o * kd);
            }
            uint2 o2; o2.x = pack2(acc[i][j][0], acc[i][j][1]); o2.y = pack2(acc[i][j][2], acc[i][j][3]);
            *(uint2*)(proj + (size_t)m * PS + n0 + wn * 64 + j * 16 + kq * 4) = o2;
          }
        }
        continue;
      }
#pragma unroll
      for (int i = 0; i < 4; ++i)
#pragma unroll
        for (int j = 0; j < 4; j += 2) {
          const int m = m0 + wm * 64 + i * 16 + (lane & 15);
          uint2 oa, ob;
          oa.x = pack2(acc[i][j][0], acc[i][j][1]); oa.y = pack2(acc[i][j][2], acc[i][j][3]);
          ob.x = pack2(acc[i][j + 1][0], acc[i][j + 1][1]); ob.y = pack2(acc[i][j + 1][2], acc[i][j + 1][3]);
          store16_pair_nt(proj + (size_t)m * PS + n0 - shift + wn * 64 + j * 16, oa, ob, lane >> 4);
        }
    }
  }
}

DI bf16x8 pack_frag(const f32x16& x, int s) {
  u32x4 p;
  asm volatile("v_cvt_pk_bf16_f32 %0, %4, %5\n\tv_cvt_pk_bf16_f32 %1, %6, %7\n\tv_cvt_pk_bf16_f32 %2, %8, %9\n\tv_cvt_pk_bf16_f32 %3, %10, %11\n\ts_nop 1"
               : "=&v"(p[0]), "=&v"(p[1]), "=&v"(p[2]), "=&v"(p[3])
               : "v"(x[8 * s]), "v"(x[8 * s + 1]), "v"(x[8 * s + 2]), "v"(x[8 * s + 3]), "v"(x[8 * s + 4]), "v"(x[8 * s + 5]), "v"(x[8 * s + 6]), "v"(x[8 * s + 7]));
  return __builtin_bit_cast(bf16x8, p);
}

DI void sb_item(const Params& p, int b, int h, int qi, unsigned char* smem) {
  bf16_t* Ks = (bf16_t*)smem;
  bf16_t* Vt = Ks + 128 * 72;
  const bf16_t* proj = (const bf16_t*)(ws_op(p) + OFF_PROJ);
  const bf16_t* svt = (const bf16_t*)(ws_op(p) + OFF_SVT);
  bf16_t* yb = (bf16_t*)(ws_op(p) + OFF_YB);
  const int tid = tid_op(), lane = tid & 63, wave = tid >> 6, r = lane & 31, h2 = lane >> 5;
  const int qpos = qi * 128 + wave * 32 + r;
  const size_t mq = (size_t)b * 2048 + qpos;
  bf16x8 qf[4];
#pragma unroll
  for (int ks = 0; ks < 4; ++ks) qf[ks] = *(const bf16x8*)(proj + mq * PS + C_SQ + h * 64 + ks * 16 + h2 * 8);
  f32x16 o[2];
#pragma unroll
  for (int i = 0; i < 16; ++i) { o[0][i] = 0.f; o[1][i] = 0.f; }
  float carry = 1.0f;
  u32x4 pk[4], pv[4];
#pragma unroll
  for (int i = 0; i < 4; ++i) {
    const int c = tid + i * 256;
    pk[i] = *(const u32x4*)(proj + ((size_t)b * 2048 + qi * 128 + (c >> 3)) * PS + C_SK + h * 64 + (c & 7) * 8);
    pv[i] = *(const u32x4*)(svt + ((size_t)((b * 8 + h) * 64 + (c >> 4))) * 2048 + qi * 128 + (c & 15) * 8);
  }
  for (int kb = qi; kb >= 0; --kb) {
    __syncthreads();
    if (kb != qi) { const volatile int* vote = (const volatile int*)(smem + 65568); if (vote[0] & vote[1] & vote[2] & vote[3]) break; }
#pragma unroll
    for (int i = 0; i < 4; ++i) {
      const int c = tid + i * 256;
      *(u32x4*)(Ks + (c >> 3) * 72 + (c & 7) * 8) = pk[i];
      *(u32x4*)(Vt + (c >> 4) * 136 + (c & 15) * 8) = pv[i];
    }
    __syncthreads();
    if (kb > 0) {
#pragma unroll
      for (int i = 0; i < 4; ++i) {
        const int c = tid + i * 256;
        pk[i] = *(const u32x4*)(proj + ((size_t)b * 2048 + (kb - 1) * 128 + (c >> 3)) * PS + C_SK + h * 64 + (c & 7) * 8);
        pv[i] = *(const u32x4*)(svt + ((size_t)((b * 8 + h) * 64 + (c >> 4))) * 2048 + (kb - 1) * 128 + (c & 15) * 8);
      }
    }
    const bool diag = (kb == qi);
    for (int kt = 3; kt >= 0; --kt) {
      f32x16 s;
#pragma unroll
      for (int i = 0; i < 16; ++i) s[i] = 0.f;
#pragma unroll
      for (int ks = 0; ks < 4; ++ks) { bf16x8 kf = *(const bf16x8*)(Ks + (kt * 32 + r) * 72 + ks * 16 + h2 * 8); s = MFMA32(kf, qf[ks], s); }
      const int keybase = kb * 128 + kt * 32 + 4 * h2;
      float kp[16];
#pragma unroll
      for (int reg = 0; reg < 16; ++reg) {
        kp[reg] = __builtin_amdgcn_rcpf(1.0f + __expf(s[reg]));
        if (diag) { const int key = keybase + (reg & 3) + 8 * (reg >> 2); kp[reg] = (key < qpos) ? kp[reg] : 1.0f; }
      }
      float G[4], Gp[4], off[4];
#pragma unroll
      for (int g = 0; g < 4; ++g) { G[g] = (kp[4 * g] * kp[4 * g + 1]) * (kp[4 * g + 2] * kp[4 * g + 3]); Gp[g] = shx(G[g], 32, lane); }
      const float T0 = G[0] * Gp[0], T1 = G[1] * Gp[1], T2 = G[2] * Gp[2], T3 = G[3] * Gp[3];
      const float st2 = T3, st1 = T3 * T2, st0 = st1 * T1, total = st0 * T0;
      off[3] = carry; off[2] = carry * st2; off[1] = carry * st1; off[0] = carry * st0;
      if (h2 == 0) { off[0] *= Gp[0]; off[1] *= Gp[1]; off[2] *= Gp[2]; off[3] *= Gp[3]; }
      f32x16 w;
#pragma unroll
      for (int g = 0; g < 4; ++g) {
        float e = off[g];
#pragma unroll
        for (int i = 3; i >= 0; --i) {
          const int reg = 4 * g + i;
          w[reg] = (1.0f - kp[reg]) * e;
          e *= kp[reg];
        }
      }
      carry *= total;
#pragma unroll
      for (int sidx = 0; sidx < 2; ++sidx) {
        const bf16x8 pf = pack_frag(w, sidx);
#pragma unroll
        for (int dt = 0; dt < 2; ++dt) {
          const bf16_t* vp = Vt + (dt * 32 + r) * 136 + kt * 32 + 16 * sidx + 4 * h2;
          const s16x4 lo = *(const s16x4*)vp, hi = *(const s16x4*)(vp + 8);
          const bf16x8 vf = __builtin_shufflevector(lo, hi, 0, 1, 2, 3, 4, 5, 6, 7);
          o[dt] = MFMA32(vf, pf, o[dt]);
        }
      }
    }
    { const int alld = __all(carry < 1e-37f); if (lane == 0) ((volatile int*)(smem + 65568))[wave] = alld ? 1 : 0; }
  }
#pragma unroll
  for (int dt = 0; dt < 2; ++dt)
#pragma unroll
    for (int gp = 0; gp < 4; gp += 2) {
      uint2 zq[2], oq[2];
      load32_pair(proj + mq * PS + C_SZ + h * 64 + dt * 32 + 8 * gp, zq[0], zq[1], h2);
#pragma unroll
      for (int q = 0; q < 2; ++q) {
        const int g = gp + q; const uint2 zz = zq[q];
        const float z0 = bf2f((bf16_t)(zz.x & 0xffff)), z1 = bf2f((bf16_t)(zz.x >> 16)), z2 = bf2f((bf16_t)(zz.y & 0xffff)), z3 = bf2f((bf16_t)(zz.y >> 16));
        oq[q].x = pack2(o[dt][4 * g] * siluf_(z0), o[dt][4 * g + 1] * siluf_(z1)); oq[q].y = pack2(o[dt][4 * g + 2] * siluf_(z2), o[dt][4 * g + 3] * siluf_(z3));
      }
      store32_pair(yb + mq * 512 + h * 64 + dt * 32 + 8 * gp, oq[0], oq[1], h2);
    }
}

DI void ret_item(const Params& p, int b, int h, int es, int part, unsigned char* smem) {
  bf16_t* Ks = (bf16_t*)smem;
  bf16_t* Vt = Ks + 64 * 136;
  bf16_t* St = Vt + 64 * 136;
  const bf16_t* proj = (const bf16_t*)(ws_op(p) + OFF_PROJ);
  const bf16_t* rvt = (const bf16_t*)(ws_op(p) + OFF_RVT);
  const bf16_t* kdt = (const bf16_t*)(ws_op(p) + OFF_KDT);
  bf16_t* ya = (bf16_t*)(ws_op(p) + OFF_YA);
  float* ssq = (float*)(ws_op(p) + OFF_SSQ);
  const int tid = tid_op(), lane = tid & 63, wave = tid >> 6, r = lane & 31, h2 = lane >> 5;
  const float lg2 = log2f(1.0f - exp2f(-5.0f - (float)h));
  const float cdec = exp2f(128.0f * lg2);
  const int il = wave * 32 + r;
  const float qdec = exp2f((float)(il + 1) * lg2);
  f32x16 st[2];
#pragma unroll
  for (int i = 0; i < 16; ++i) { st[0][i] = 0.f; st[1][i] = 0.f; }
  const size_t vrow0 = (size_t)((b * 4 + h) * 256 + es * 64);
  const size_t krow = (size_t)((b * 4 + h) * 128 + wave * 32 + r);
  const int srow = tid >> 4, skc = (tid & 15) * 8;
  if (part) {
    for (int n = 0; n < 8; ++n) {
      bf16x8 kdf[8];
#pragma unroll
      for (int ks = 0; ks < 8; ++ks) kdf[ks] = *(const bf16x8*)(kdt + krow * 2048 + n * 128 + ks * 16 + h2 * 8);
      __syncthreads();
#pragma unroll
      for (int i = 0; i < 4; ++i) { const int row = srow + i * 16; *(u32x4*)(Vt + row * 136 + skc) = *(const u32x4*)(rvt + (vrow0 + row) * 2048 + n * 128 + skc); }
      __syncthreads();
#pragma unroll
      for (int i = 0; i < 16; ++i) { st[0][i] *= cdec; st[1][i] *= cdec; }
#pragma unroll
      for (int ks = 0; ks < 8; ++ks)
#pragma unroll
        for (int et = 0; et < 2; ++et) { const bf16x8 vf = *(const bf16x8*)(Vt + (et * 32 + r) * 136 + ks * 16 + h2 * 8); st[et] = MFMA32(vf, kdf[ks], st[et]); }
    }
  }
  for (int n = part * 8; n < part * 8 + 8; ++n) {
    const size_t mq = (size_t)b * 2048 + n * 128 + il;
    bf16x8 qf[8];
#pragma unroll
    for (int ks = 0; ks < 8; ++ks) qf[ks] = *(const bf16x8*)(proj + mq * PS + C_RQ + h * 128 + ks * 16 + h2 * 8);
    __syncthreads();
#pragma unroll
    for (int et = 0; et < 2; ++et)
#pragma unroll
      for (int reg = 0; reg < 16; ++reg) St[(et * 32 + crow(reg, h2)) * 136 + wave * 32 + r] = f2bf(st[et][reg]);
#pragma unroll
    for (int i = 0; i < 4; ++i) {
      const int row = srow + i * 16;
      *(u32x4*)(Vt + row * 136 + skc) = *(const u32x4*)(rvt + (vrow0 + row) * 2048 + n * 128 + skc);
      *(u32x4*)(Ks + row * 136 + skc) = *(const u32x4*)(proj + ((size_t)b * 2048 + n * 128 + row) * PS + C_RK + h * 128 + skc);
    }
    __syncthreads();
    f32x16 o[2];
#pragma unroll
    for (int i = 0; i < 16; ++i) { o[0][i] = 0.f; o[1][i] = 0.f; }
#pragma unroll
    for (int ks = 0; ks < 8; ++ks)
#pragma unroll
      for (int et = 0; et < 2; ++et) { const bf16x8 sf = *(const bf16x8*)(St + (et * 32 + r) * 136 + ks * 16 + h2 * 8); o[et] = MFMA32(sf, qf[ks], o[et]); }
#pragma unroll
    for (int i = 0; i < 16; ++i) { o[0][i] *= qdec; o[1][i] *= qdec; }
    for (int jh = 0; jh < 2; ++jh) {
      if (jh) {
        __syncthreads();
#pragma unroll
        for (int i = 0; i < 4; ++i) {
          const int row = srow + i * 16;
          *(u32x4*)(Ks + row * 136 + skc) = *(const u32x4*)(proj + ((size_t)b * 2048 + n * 128 + 64 + row) * PS + C_RK + h * 128 + skc);
        }
        __syncthreads();
      }
      for (int kt = 0; kt < 2; ++kt) {
        const int key0 = jh * 64 + kt * 32;
        if (key0 > wave * 32 + 31) continue;
        f32x16 s;
#pragma unroll
        for (int i = 0; i < 16; ++i) s[i] = 0.f;
#pragma unroll
        for (int ks = 0; ks < 8; ++ks) { const bf16x8 kf = *(const bf16x8*)(Ks + (kt * 32 + r) * 136 + ks * 16 + h2 * 8); s = MFMA32(kf, qf[ks], s); }
#pragma unroll
        for (int reg = 0; reg < 16; ++reg) {
          const int dl = il - (key0 + crow(reg, h2));
          s[reg] = (dl >= 0) ? s[reg] * __builtin_amdgcn_exp2f((float)dl * lg2) : 0.f;
        }
#pragma unroll
        for (int sidx = 0; sidx < 2; ++sidx) {
          const bf16x8 pf = pack_frag(s, sidx);
#pragma unroll
          for (int et = 0; et < 2; ++et) {
            const bf16_t* vp = Vt + (et * 32 + r) * 136 + key0 + 16 * sidx + 4 * h2;
            const s16x4 lo = *(const s16x4*)vp, hi = *(const s16x4*)(vp + 8);
            const bf16x8 vf = __builtin_shufflevector(lo, hi, 0, 1, 2, 3, 4, 5, 6, 7);
            o[et] = MFMA32(vf, pf, o[et]);
          }
        }
      }
    }
    bf16x8 kdf[8];
#pragma unroll
    for (int ks = 0; ks < 8; ++ks) kdf[ks] = *(const bf16x8*)(kdt + krow * 2048 + n * 128 + ks * 16 + h2 * 8);
    float ss = 0.f;
#pragma unroll
    for (int i = 0; i < 16; ++i) ss += o[0][i] * o[0][i] + o[1][i] * o[1][i];
    ss += shx(ss, 32, lane);
    if (h2 == 0) ssq[mq * 16 + h * 4 + es] = ss;
#pragma unroll
    for (int et = 0; et < 2; ++et)
#pragma unroll
      for (int g = 0; g < 4; g += 2) {
        uint2 oa, ob;
        oa.x = pack2(o[et][4 * g], o[et][4 * g + 1]); oa.y = pack2(o[et][4 * g + 2], o[et][4 * g + 3]);
        ob.x = pack2(o[et][4 * g + 4], o[et][4 * g + 5]); ob.y = pack2(o[et][4 * g + 6], o[et][4 * g + 7]);
        store32_pair(ya + mq * 1024 + h * 256 + es * 64 + et * 32 + 8 * g, oa, ob, h2);
      }
#pragma unroll
    for (int i = 0; i < 16; ++i) { st[0][i] *= cdec; st[1][i] *= cdec; }
#pragma unroll
    for (int ks = 0; ks < 8; ++ks)
#pragma unroll
      for (int et = 0; et < 2; ++et) { const bf16x8 vf = *(const bf16x8*)(Vt + (et * 32 + r) * 136 + ks * 16 + h2 * 8); st[et] = MFMA32(vf, kdf[ks], st[et]); }
  }
}

DI void ret_finalize(const Params& p, int layer) {
  const bf16_t* proj = (const bf16_t*)(ws_op(p) + OFF_PROJ);
  bf16_t* ya = (bf16_t*)(ws_op(p) + OFF_YA);
  const float* ssq = (const float*)(ws_op(p) + OFF_SSQ);
  const float* gn = p.in[5] + layer * 1024;
  const int tid = tid_op();
  constexpr int U = 4;
  const int stride = (int)gridDim.x * 256;
  for (int base = (int)blockIdx.x * 256 + tid; base < TH * 128; base += stride * U) {
    f32x4 s4[U]; u32x4 ov[U], zv[U];
#pragma unroll
    for (int u = 0; u < U; ++u) {
      const int idx = base + u * stride;
      if (idx < TH * 128) {
        const size_t tok = idx >> 7; const int c8 = (idx & 127) * 8, head = c8 >> 8;
        s4[u] = *(const f32x4*)(ssq + tok * 16 + head * 4);
        ov[u] = *(const u32x4*)(ya + tok * 1024 + c8);
        zv[u] = *(const u32x4*)(proj + tok * PS + C_RZ + c8);
      }
    }
#pragma unroll
    for (int u = 0; u < U; ++u) {
      const int idx = base + u * stride;
      if (idx < TH * 128) {
        const size_t tok = idx >> 7; const int c8 = (idx & 127) * 8;
        const float rstd = rsqrtf((s4[u][0] + s4[u][1] + s4[u][2] + s4[u][3]) * (1.0f / 256.0f) + EPS);
        const f32x4 g0 = *(const f32x4*)(gn + c8), g1 = *(const f32x4*)(gn + c8 + 4);
        u32x4 res;
#pragma unroll
        for (int q = 0; q < 4; ++q) {
          const float o0 = bf2f((bf16_t)(ov[u][q] & 0xffff)), o1 = bf2f((bf16_t)(ov[u][q] >> 16));
          const float z0 = bf2f((bf16_t)(zv[u][q] & 0xffff)), z1 = bf2f((bf16_t)(zv[u][q] >> 16));
          const float ga = (q < 2) ? g0[2 * q] : g1[2 * q - 4], gb = (q < 2) ? g0[2 * q + 1] : g1[2 * q - 3];
          res[q] = pack2(o0 * rstd * ga * siluf_(z0), o1 * rstd * gb * siluf_(z1));
        }
        *(u32x4*)(ya + tok * 1024 + c8) = res;
      }
    }
  }
}

DI void ssm_item(const Params& p, int layer, int b, int g, unsigned char* smem) {
  float* Ss = (float*)smem;
  bf16_t* KTs = (bf16_t*)smem;
  bf16_t* Hp = (bf16_t*)(smem + 33792);
  const bf16_t* proj = (const bf16_t*)(ws_op(p) + OFF_PROJ);
  bf16_t* ycp = (bf16_t*)(ws_op(p) + OFF_YCP);
  const int gi = layer * 32 + g;
  const unsigned char* tb = ws_op(p) + OFF_SSMT + (size_t)gi * SSMT_STRIDE;
  const bf16_t* KTg = (const bf16_t*)(tb + SSMT_KT); const bf16_t* Pg = (const bf16_t*)(tb + SSMT_P); const bf16_t* Qg = (const bf16_t*)(tb + SSMT_Q);
  const float* a32 = (const float*)(tb + SSMT_A32);
  const int tid = tid_op(), lane = tid & 63, wave = tid >> 6, fr = lane & 15, kq = lane >> 4;
  const int chunk = wave * 16 + fr;
  const bf16_t* ubase = proj + ((size_t)b * 2048 + chunk * 32 + (kq >> 1)) * PS + C_CU + g * 16 + 8 * (kq & 1);
  bf16x8 ub[16];
#pragma unroll
  for (int jp = 0; jp < 16; ++jp) ub[jp] = *(const bf16x8*)(ubase + (size_t)(2 * jp) * PS);
  __syncthreads();
#pragma unroll 1
  for (int mt = 0; mt < 8; ++mt) {
    f32x4 acc = {0.f, 0.f, 0.f, 0.f};
    const bf16_t* prow = Pg + (size_t)(mt * 16 + fr) * 512 + kq * 8;
#pragma unroll
    for (int ks = 0; ks < 16; ++ks) { const bf16x8 pf = *(const bf16x8*)(prow + ks * 32); acc = MFMA16(pf, ub[ks], acc); }
    *(f32x4*)(Ss + chunk * 132 + mt * 16 + kq * 4) = acc;
  }
  __syncthreads();
  if (wave == 0) {
    const float ar = a32[lane], ai = a32[64 + lane];
    float hr = 0.f, hi = 0.f;
    for (int c = 0; c < 64; ++c) {
      Hp[c * 136 + lane] = f2bf(hr); Hp[c * 136 + 64 + lane] = f2bf(hi);
      const float sr = Ss[c * 132 + lane], si = Ss[c * 132 + 64 + lane];
      const float nr = ar * hr - ai * hi + sr, ni = ar * hi + ai * hr + si;
      hr = nr; hi = ni;
    }
  }
  __syncthreads();
  for (int c = tid; c < 1056; c += 256) *(u32x4*)(KTs + c * 8) = *(const u32x4*)(KTg + c * 8);
  __syncthreads();
  float dsk[4];
#pragma unroll
  for (int i = 0; i < 4; ++i) dsk[i] = p.in[15][layer * 512 + g * 16 + kq * 4 + i];
  const int th = kq >> 1;
  const bf16_t* ktl = KTs + fr * 16 + 8 * (kq & 1);
#pragma unroll 1
  for (int ih = 0; ih < 2; ++ih) {
    f32x4 acc[16];
#pragma unroll
    for (int ii = 0; ii < 16; ++ii) {
      acc[ii] = f32x4{0.f, 0.f, 0.f, 0.f};
      const bf16_t* qrow = Qg + (size_t)((ih * 16 + ii) * 16 + fr) * 128 + kq * 8;
#pragma unroll
      for (int ks = 0; ks < 4; ++ks) { const bf16x8 qf = *(const bf16x8*)(qrow + ks * 32); const bf16x8 hbk = *(const bf16x8*)(Hp + chunk * 136 + ks * 32 + kq * 8); acc[ii] = MFMA16(qf, hbk, acc[ii]); }
    }
    if (ih == 0) {
#pragma unroll
      for (int ii = 0; ii < 16; ++ii)
#pragma unroll
        for (int jp = 0; jp <= (ii >> 1); ++jp) {
          const int t1 = ii - 2 * jp - th + 1;
          const bf16x8 kf = *(const bf16x8*)(ktl + t1 * 256);
          acc[ii] = MFMA16(kf, ub[jp], acc[ii]);
        }
    } else {
#pragma unroll
      for (int ii = 0; ii < 16; ++ii)
#pragma unroll
        for (int jp = 0; jp <= ((16 + ii) >> 1); ++jp) {
          const int t1 = 16 + ii - 2 * jp - th + 1;
          const bf16x8 kf = *(const bf16x8*)(ktl + t1 * 256);
          acc[ii] = MFMA16(kf, ub[jp], acc[ii]);
        }
    }
#pragma unroll
    for (int ii = 0; ii < 16; ii += 2) {
      const size_t tok = (size_t)b * 2048 + chunk * 32 + ih * 16 + ii;
      uint2 uq[2], oq[2];
      load16_pair(proj + tok * PS + C_CU + g * 16, uq[0], uq[1], kq, PS);
#pragma unroll
      for (int q = 0; q < 2; ++q) {
        const uint2 uu = uq[q];
        const float y0 = gelu_tanh(acc[ii + q][0] + dsk[0] * bf2f((bf16_t)(uu.x & 0xffff)));
        const float y1 = gelu_tanh(acc[ii + q][1] + dsk[1] * bf2f((bf16_t)(uu.x >> 16)));
        const float y2 = gelu_tanh(acc[ii + q][2] + dsk[2] * bf2f((bf16_t)(uu.y & 0xffff)));
        const float y3 = gelu_tanh(acc[ii + q][3] + dsk[3] * bf2f((bf16_t)(uu.y >> 16)));
        oq[q].x = pack2(y0, y1); oq[q].y = pack2(y2, y3);
      }
      store16_pair(ycp + tok * 512 + g * 16, oq[0], oq[1], kq, 512);
    }
  }
}

DI void phase_mixers(const Params& p, int layer, int half, unsigned char* smem) {
  const int NI = 256 + 256 + 1024;
  int* ctr = (int*)(ws_op(p) + OFF_CTR) + (layer * 2 + half);
  int* s_item = (int*)(smem + 65536);
  const int tid = tid_op();
  for (;;) {
    __syncthreads();
    if (tid == 0) *s_item = atomicAdd(ctr, 1);
    __syncthreads();
    const int id = *s_item;
    if (id >= NI) break;
    if (id < 256) ssm_item(p, layer, id >> 5, id & 31, smem);
    else if (id < 512) { const int j = id - 256, q = j & 127; ret_item(p, q >> 4, (q >> 2) & 3, q & 3, 1 - (j >> 7), smem); }
    else { const int j = id - 512, r = j & 63; sb_item(p, r >> 3, r & 7, 15 - (j >> 6), smem); }
  }
}

DI void phase_glu(const Params& p, int layer, unsigned char* smem) {
  const bf16_t* ycp = (const bf16_t*)(ws_op(p) + OFF_YCP);
  const bf16_t* WT = (const bf16_t*)(ws_op(p) + OFF_WT) + (size_t)layer * LAYER_W + W_GLU_T;
  const bf16_t* proj = (const bf16_t*)(ws_op(p) + OFF_PROJ);
  bf16_t* yc = (bf16_t*)(ws_op(p) + OFF_YC);
  const float* bg = p.in[17] + layer * 512;
  const int tid_ = tid_op(), lane = tid_ & 63, wave = tid_ >> 6, wm = wave >> 1, wn = wave & 1;
  for (int t = (int)blockIdx.x; t < 128 * 4; t += gridDim.x) {
    const int m0 = (t >> 2) * 128, n0 = (t & 3) * 128;
    f32x4 acc[4][4]; zero_acc<4>(acc);
    gemm_core<true, 4>(ycp + (size_t)m0 * 512, 512, WT + (size_t)n0 * 512, 512, 512, acc, smem);
#pragma unroll
    for (int i = 0; i < 4; ++i)
#pragma unroll
      for (int jp = 0; jp < 4; jp += 2) {
        const size_t m = m0 + wm * 64 + i * 16 + (lane & 15); const int nb = n0 + wn * 64 + jp * 16;
        uint2 yq[2], zq[2], oq[2];
        load16_pair(ycp + m * 512 + nb, yq[0], yq[1], lane >> 4);
        load16_pair(proj + m * PS + C_CZ + nb, zq[0], zq[1], lane >> 4);
#pragma unroll
        for (int q = 0; q < 2; ++q) {
          const int j = jp + q; const uint2 yy = yq[q], zz = zq[q];
          const float4 b4 = *(const float4*)(bg + nb + q * 16 + (lane >> 4) * 4);
          const float y0 = bf2f((bf16_t)(yy.x & 0xffff)), y1 = bf2f((bf16_t)(yy.x >> 16)), y2 = bf2f((bf16_t)(yy.y & 0xffff)), y3 = bf2f((bf16_t)(yy.y >> 16));
          const float z0 = bf2f((bf16_t)(zz.x & 0xffff)), z1 = bf2f((bf16_t)(zz.x >> 16)), z2 = bf2f((bf16_t)(zz.y & 0xffff)), z3 = bf2f((bf16_t)(zz.y >> 16));
          oq[q].x = pack2(y0 * sigmoidf_(acc[i][j][0] + b4.x) * siluf_(z0), y1 * sigmoidf_(acc[i][j][1] + b4.y) * siluf_(z1));
          oq[q].y = pack2(y2 * sigmoidf_(acc[i][j][2] + b4.z) * siluf_(z2), y3 * sigmoidf_(acc[i][j][3] + b4.w) * siluf_(z3));
        }
        store16_pair(yc + m * 512 + nb, oq[0], oq[1], lane >> 4);
      }
  }
}

DI void phase_merge(const Params& p, int layer, unsigned char* smem) {
  const bf16_t* wl = (const bf16_t*)(ws_op(p) + OFF_WT) + (size_t)layer * LAYER_W;
  const bf16_t* ya = (const bf16_t*)(ws_op(p) + OFF_YA);
  const bf16_t* yb = (const bf16_t*)(ws_op(p) + OFF_YB);
  const bf16_t* yc = (const bf16_t*)(ws_op(p) + OFF_YC);
  const bf16_t* proj = (const bf16_t*)(ws_op(p) + OFF_PROJ);
  bf16_t* merged = (bf16_t*)(ws_op(p) + OFF_H);
  const int tid_ = tid_op(), lane = tid_ & 63, wave = tid_ >> 6, wm = wave >> 1, wn = wave & 1;
  for (int t = (int)blockIdx.x; t < 128 * 8; t += gridDim.x) {
    const int m0 = (t >> 3) * 128, n0 = (t & 7) * 128;
    f32x4 mg[4][4]; zero_acc<4>(mg);
#pragma unroll 1
    for (int br = 0; br < 3; ++br) {
      f32x4 acc[4][4]; zero_acc<4>(acc);
      if (br == 0) gemm_core<true, 4>(ya + (size_t)m0 * 1024, 1024, wl + PA_T + (size_t)n0 * 1024, 1024, 1024, acc, smem);
      else if (br == 1) gemm_core<true, 4>(yb + (size_t)m0 * 512, 512, wl + PB_T + (size_t)n0 * 512, 512, 512, acc, smem);
      else gemm_core<true, 4>(yc + (size_t)m0 * 512, 512, wl + PC_T + (size_t)n0 * 512, 512, 512, acc, smem);
      const int gcol = (br == 0) ? C_GA : (br == 1 ? C_GB : C_GC);
#pragma unroll
      for (int i = 0; i < 4; ++i)
#pragma unroll
        for (int jp = 0; jp < 4; jp += 2) {
          const size_t m = m0 + wm * 64 + i * 16 + (lane & 15);
          uint2 gq[2];
          load16_pair(proj + m * PS + gcol + n0 + wn * 64 + jp * 16, gq[0], gq[1], lane >> 4);
#pragma unroll
          for (int q = 0; q < 2; ++q) {
            const int j = jp + q; const uint2 gg = gq[q];
            mg[i][j][0] += sigmoidf_(bf2f((bf16_t)(gg.x & 0xffff))) * acc[i][j][0];
            mg[i][j][1] += sigmoidf_(bf2f((bf16_t)(gg.x >> 16))) * acc[i][j][1];
            mg[i][j][2] += sigmoidf_(bf2f((bf16_t)(gg.y & 0xffff))) * acc[i][j][2];
            mg[i][j][3] += sigmoidf_(bf2f((bf16_t)(gg.y >> 16))) * acc[i][j][3];
          }
        }
    }
#pragma unroll
    for (int i = 0; i < 4; ++i)
#pragma unroll
      for (int j = 0; j < 4; j += 2) {
        const size_t m = m0 + wm * 64 + i * 16 + (lane & 15);
        uint2 oa, ob;
        oa.x = pack2(mg[i][j][0], mg[i][j][1]); oa.y = pack2(mg[i][j][2], mg[i][j][3]);
        ob.x = pack2(mg[i][j + 1][0], mg[i][j + 1][1]); ob.y = pack2(mg[i][j + 1][2], mg[i][j + 1][3]);
        store16_pair(merged + m * 1024 + n0 + wn * 64 + j * 16, oa, ob, lane >> 4);
      }
  }
}

DI void phase_out(const Params& p, int layer, int half, unsigned char* smem) {
  const bf16_t* wl = (const bf16_t*)(ws_op(p) + OFF_WT) + (size_t)layer * LAYER_W;
  const bf16_t* merged = (const bf16_t*)(ws_op(p) + OFF_H);
  const float* xin = (layer == 0 ? p.in[0] : p.out) + (size_t)half * TH * DM;
  float* xout = p.out + (size_t)half * TH * DM;
  const int tid_ = tid_op(), lane = tid_ & 63, wave = tid_ >> 6, wm = wave >> 1, wn = wave & 1;
  for (int t = (int)blockIdx.x; t < 64 * 8; t += gridDim.x) {
    const int m0 = (t >> 3) * 256, n0 = (t & 7) * 128;
    f32x4 acc[8][4]; zero_acc8(acc);
    gemm_core256<true>(merged + (size_t)m0 * 1024, 1024, wl + WO_T + (size_t)n0 * 1024, 1024, 1024, acc, smem);
#pragma unroll
    for (int i = 0; i < 8; ++i)
#pragma unroll
      for (int j = 0; j < 4; ++j) {
        const size_t m = m0 + wm * 128 + i * 16 + (lane & 15); const int n = n0 + wn * 64 + j * 16 + (lane >> 4) * 4;
        const f32x4 xv = __builtin_nontemporal_load((const f32x4*)(xin + m * DM + n));
        const f32x4 ov = xv + acc[i][j];
        if (layer == 1) __builtin_nontemporal_store(ov, (f32x4*)(xout + m * DM + n));
        else *(f32x4*)(xout + m * DM + n) = ov;
      }
  }
}

#define XB_TMO      128
#define XB_XCNT(j)  (256  + 64 * (j))
#define XB_XSUB(j)  (1280 + 64 * (j))
#define XB_XGEN(j)  (2304 + 64 * (j))
#define XB_TOP      3328
#define XB_TOPGEN   3392
#define XCD_BAR_WORDS 3456
#define XB_SPIN_CAP (1u << 18)
DI unsigned xb_ld(unsigned* p) { return __hip_atomic_load(p, __ATOMIC_RELAXED, __HIP_MEMORY_SCOPE_AGENT); }
DI unsigned xb_add(unsigned* p, unsigned v) { return __hip_atomic_fetch_add(p, v, __ATOMIC_RELAXED, __HIP_MEMORY_SCOPE_AGENT); }
DI unsigned xb_xcc_id() { return (unsigned)__builtin_amdgcn_s_getreg((3 << 11) | 20) & 0xFu; }
#define XB_SPIN(cond, bar) do { unsigned _sp = 0; while (cond) { __builtin_amdgcn_s_sleep(1); \
    if ((++_sp & 255u) == 0u) { if (xb_ld(&(bar)[XB_TMO])) break; if (_sp > XB_SPIN_CAP) { atomicAdd(&(bar)[XB_TMO], 1u); break; } } } } while (0)
struct XcdBarrier { unsigned* bar; unsigned x; volatile unsigned* st; };
DI XcdBarrier xcd_barrier_post(unsigned* bar, volatile unsigned* st) {
  XcdBarrier b; b.bar = bar; b.x = xb_xcc_id(); b.st = st;
  if (threadIdx.x == 0) (void)xb_add(&bar[XB_XCNT(b.x)], 1u);
  return b;
}
DI void xcd_barrier_complete(unsigned* bar, unsigned x, unsigned& nloc, unsigned& nx) {
  const unsigned G = gridDim.x;
  unsigned sum, cnt, mine, sp = 0u;
  for (;;) {
    sum = 0u; cnt = 0u; mine = 0u;
#pragma unroll
    for (unsigned j = 0; j < 16; ++j) { const unsigned c = xb_ld(&bar[XB_XCNT(j)]); sum += c; cnt += (c > 0u) ? 1u : 0u; mine = (j == x) ? c : mine; }
    if (sum == G) break;
    __builtin_amdgcn_s_sleep(1);
    if ((++sp & 255u) == 0u) { if (xb_ld(&bar[XB_TMO])) break; if (sp > XB_SPIN_CAP) { atomicAdd(&bar[XB_TMO], 1u); break; } }
  }
  nloc = mine > 0u ? mine : 1u; nx = cnt > 0u ? cnt : 1u;
}
DI void xcd_barrier(const XcdBarrier& b_unused, const Params& p, unsigned char* smem) {
  XcdBarrier b; b.x = xb_xcc_id(); b.st = (volatile unsigned*)(smem + 65552); b.bar = nullptr;
  asm volatile("s_waitcnt vmcnt(0)" ::: "memory");
  __syncthreads();
  if (threadIdx.x == 0) {
    unsigned* bar = (unsigned*)(ws_op(p) + OFF_BAR);
    __builtin_amdgcn_s_waitcnt(0);
    unsigned nloc = b.st[0], nx = b.st[1];
    if (nloc == 0u) { xcd_barrier_complete(bar, b.x, nloc, nx); b.st[0] = nloc; b.st[1] = nx; }
    const unsigned old = xb_add(&bar[XB_XSUB(b.x)], 1u);
    const unsigned gen = old / nloc;
    if (old + 1u == (gen + 1u) * nloc) {
      __builtin_amdgcn_fence(__ATOMIC_RELEASE, "agent");
      asm volatile("s_waitcnt vmcnt(0)" ::: "memory");
      const unsigned og = xb_add(&bar[XB_TOP], 1u);
      const unsigned tg = og / nx;
      if (og + 1u == (tg + 1u) * nx) xb_add(&bar[XB_TOPGEN], 1u);
      else XB_SPIN(xb_ld(&bar[XB_TOPGEN]) == tg, bar);
      __builtin_amdgcn_fence(__ATOMIC_ACQUIRE, "agent");
      xb_add(&bar[XB_XGEN(b.x)], 1u);
      asm volatile("s_waitcnt vmcnt(0)" ::: "memory");
    } else {
      XB_SPIN(xb_ld(&bar[XB_XGEN(b.x)]) == gen, bar);
      __builtin_amdgcn_fence(__ATOMIC_ACQUIRE, "agent");
      asm volatile("s_waitcnt vmcnt(0)" ::: "memory");
    }
  }
  __syncthreads();
}

__global__ void __launch_bounds__(256, 2) fwd_megakernel(Params p) {
  cg::grid_group grid = cg::this_grid();
  extern __shared__ __attribute__((aligned(1024))) unsigned char smem[];
  volatile unsigned* xst = (volatile unsigned*)(smem + 65552);
  if (threadIdx.x == 0) { xst[0] = 0u; xst[1] = 0u; }
  __syncthreads();
  const XcdBarrier xb = xcd_barrier_post((unsigned*)(ws_op(p) + OFF_BAR), xst);
  phase_prologue(p, smem);
  phase_norm(p, 0, 0);
  if (p.use_cg_sync) grid.sync();
  xcd_barrier(xb, p, smem);
  for (int layer = 0; layer < 2; ++layer)
    for (int half = 0; half < 2; ++half) {
      if (layer | half) { phase_norm(p, layer, half); xcd_barrier(xb, p, smem); }
      phase_inproj(p, layer, smem);
      xcd_barrier(xb, p, smem);
      phase_mixers(p, layer, half, smem);
      xcd_barrier(xb, p, smem);
      phase_glu(p, layer, smem);
      ret_finalize(p, layer);
      xcd_barrier(xb, p, smem);
      phase_merge(p, layer, smem);
      xcd_barrier(xb, p, smem);
      phase_out(p, layer, half, smem);
      xcd_barrier(xb, p, smem);
    }
}

extern "C" void kernel_launch(void* const* d_in, const int* in_sizes, int n_in, void* d_out, int out_size, void* d_ws, size_t ws_size, hipStream_t stream) {
  static int grid_blocks = 0;
  if (grid_blocks == 0) {
    if (n_in != 22 || ws_size < WS_END) { fprintf(stderr, "kernel_launch: unexpected n_in %d or ws_size %zu (need %zu)\n", n_in, ws_size, (size_t)WS_END); grid_blocks = -1; return; }
    int dev = 0, cus = 0, per_cu = 0;
    hipGetDevice(&dev);
    hipDeviceGetAttribute(&cus, hipDeviceAttributeMultiprocessorCount, dev);
    if (hipFuncSetAttribute((const void*)fwd_megakernel, hipFuncAttributeMaxDynamicSharedMemorySize, SMEM_BYTES) != hipSuccess) { fprintf(stderr, "kernel_launch: hipFuncSetAttribute failed\n"); grid_blocks = -1; return; }
    hipOccupancyMaxActiveBlocksPerMultiprocessor(&per_cu, fwd_megakernel, 256, SMEM_BYTES);
    if (per_cu > 2) per_cu = 2;
    if (per_cu < 1) per_cu = 1;
    grid_blocks = cus * per_cu;
  }
  if (grid_blocks < 0) return;
  Params p{};
  for (int i = 0; i < 22; ++i) p.in[i] = (const float*)d_in[i];
  p.out = (float*)d_out; p.ws = (unsigned char*)d_ws; p.use_cg_sync = 0; p.pad_ = 0;
  if (hipMemsetAsync((unsigned char*)d_ws + OFF_CTR, 0, 256 + 3456 * 4, stream) != hipSuccess) { fprintf(stderr, "kernel_launch: memset of control words failed\n"); return; }
  void* args[] = {&p};
  hipError_t e = hipLaunchCooperativeKernel((void*)fwd_megakernel, dim3(grid_blocks), dim3(256), args, SMEM_BYTES, stream);
  if (e != hipSuccess) fprintf(stderr, "cooperative launch failed: %s (grid %d)\n", hipGetErrorString(e), grid_blocks);
}
```

```cpp
#include <hip/hip_runtime.h>
#include <hip/hip_cooperative_groups.h>
#include <cstdio>
#include <cstdint>
namespace cg = cooperative_groups;

typedef unsigned short bf16_t;
typedef short bf16x8 __attribute__((ext_vector_type(8)));
typedef short s16x4 __attribute__((ext_vector_type(4)));
typedef float f32x4 __attribute__((ext_vector_type(4)));
typedef float f32x16 __attribute__((ext_vector_type(16)));
typedef unsigned u32x4 __attribute__((ext_vector_type(4)));
#define DI __device__ __forceinline__
#define MFMA16(a, b, c) __builtin_amdgcn_mfma_f32_16x16x32_bf16((a), (b), (c), 0, 0, 0)
#define MFMA32(a, b, c) __builtin_amdgcn_mfma_f32_32x32x16_bf16((a), (b), (c), 0, 0, 0)

constexpr int DM = 1024, SEQ = 2048, HB = 8, TH = HB * SEQ  , PS = 7680  ;
constexpr float EPS = 1e-6f;
constexpr int C_RQ = 0, C_RK = 512, C_RZ = 1024, C_SQ = 2048, C_SK = 2560, C_SZ = 3072, C_CU = 3584, C_CZ = 4096, C_GA = 4608, C_GB = 5632, C_GC = 6656;
constexpr size_t W_IN_T = 0, W_GLU_T = 9437184, PA_T = 9699328, PB_T = 10747904, PC_T = 11272192, WO_T = 11796480, LAYER_W = 12845056;
constexpr size_t OFF_WT = 0;
constexpr size_t OFF_ROPE = 2 * LAYER_W * 2;
constexpr size_t OFF_H = OFF_ROPE + 2 * 2048 * 64 * 4;
constexpr size_t OFF_PROJ = OFF_H + (size_t)TH * 1024 * 2;
constexpr size_t OFF_RVT = OFF_PROJ + (size_t)TH * PS * 2;
constexpr size_t OFF_SVT = OFF_RVT + (size_t)8 * 4 * 256 * 2048 * 2;
constexpr size_t OFF_YA = OFF_SVT + (size_t)8 * 8 * 64 * 2048 * 2;
constexpr size_t OFF_YB = OFF_YA + (size_t)TH * 1024 * 2;
constexpr size_t OFF_YCP = OFF_YB + (size_t)TH * 512 * 2;
constexpr size_t OFF_YC = OFF_YCP + (size_t)TH * 512 * 2;
constexpr size_t OFF_KDT = OFF_YC + (size_t)TH * 512 * 2;
constexpr size_t OFF_SSQ = OFF_KDT + (size_t)8 * 4 * 128 * 2048 * 2;
constexpr size_t SSMT_KT = 0, SSMT_P = 16896, SSMT_Q = 16896 + 131072, SSMT_A32 = 16896 + 2 * 131072, SSMT_STRIDE = 16896 + 2 * 131072 + 512;
constexpr size_t OFF_SSMT = OFF_SSQ + (size_t)TH * 16 * 4;
constexpr size_t OFF_CTR = OFF_SSMT + 64 * SSMT_STRIDE;
constexpr size_t OFF_BAR = OFF_CTR + 256;
constexpr size_t WS_END = OFF_BAR + 3456 * 4;
static_assert(WS_END <= 536870912, "workspace map exceeds 4x the largest tensor");

constexpr int SMEM_BYTES = 67584;

struct Params { const float* in[22]; float* out; unsigned char* ws; int use_cg_sync; int pad_; };

DI unsigned char* ws_op(const Params& p) { size_t z = 0; asm volatile("" : "+s"(z)); return p.ws + z; }
DI float shx(float v, int k, int lane) { return __builtin_bit_cast(float, __builtin_amdgcn_ds_bpermute((lane ^ k) << 2, __builtin_bit_cast(int, v))); }
DI float bf2f(bf16_t v) { return __uint_as_float(((unsigned)v) << 16); }
DI bf16_t f2bf(float x) { unsigned u = __float_as_uint(x); u += 0x7fffu + ((u >> 16) & 1u); return (bf16_t)(u >> 16); }
DI unsigned pack2(float lo, float hi) { unsigned r; asm volatile("v_cvt_pk_bf16_f32 %0, %1, %2" : "=v"(r) : "v"(lo), "v"(hi)); return r; }
DI float sigmoidf_(float x) { return __builtin_amdgcn_rcpf(1.0f + __expf(-x)); }
DI float siluf_(float x) { return x * sigmoidf_(x); }
DI float gelu_tanh(float y) { float a = 0.7978845608028654f * (y + 0.044715f * y * y * y); float t = 1.0f - 2.0f * __builtin_amdgcn_rcpf(__expf(2.0f * a) + 1.0f); return 0.5f * y * (1.0f + t); }
DI void swap16(unsigned& a, unsigned& b) { asm volatile("v_nop\n\tv_nop\n\tv_permlane16_swap_b32 %0, %1" : "+v"(a), "+v"(b)); }
DI void store16_pair(bf16_t* rowp, uint2 a, uint2 b, int kq, int odd_off = 16) {
  swap16(a.x, b.x); swap16(a.y, b.y);
  *(u32x4*)(rowp + (kq & 1) * odd_off + (kq >> 1) * 8) = u32x4{a.x, a.y, b.x, b.y};
}
DI void store16_pair_nt(bf16_t* rowp, uint2 a, uint2 b, int kq, int odd_off = 16) {
  swap16(a.x, b.x); swap16(a.y, b.y);
  __builtin_nontemporal_store(u32x4{a.x, a.y, b.x, b.y}, (u32x4*)(rowp + (kq & 1) * odd_off + (kq >> 1) * 8));
}
DI const u32x4* pair_ptr(const bf16_t* rowp, int kq, int odd_off = 16) { return (const u32x4*)(rowp + (kq & 1) * odd_off + (kq >> 1) * 8); }
DI void unpack16_pair(const u32x4& v, uint2& a, uint2& b) { a.x = v[0]; a.y = v[1]; b.x = v[2]; b.y = v[3]; swap16(a.x, b.x); swap16(a.y, b.y); }
DI void load16_pair(const bf16_t* rowp, uint2& a, uint2& b, int kq, int odd_off = 16) {
  const u32x4 v = *(const u32x4*)(rowp + (kq & 1) * odd_off + (kq >> 1) * 8);
  a.x = v[0]; a.y = v[1]; b.x = v[2]; b.y = v[3];
  swap16(a.x, b.x); swap16(a.y, b.y);
}
DI void swap32(unsigned& a, unsigned& b) { asm volatile("v_nop\n\tv_nop\n\tv_permlane32_swap_b32 %0, %1" : "+v"(a), "+v"(b)); }
DI void store32_pair(bf16_t* p8  , uint2 a, uint2 b, int h2) {
  swap32(a.x, b.x); swap32(a.y, b.y);
  *(u32x4*)(p8 + h2 * 8) = u32x4{a.x, a.y, b.x, b.y};
}
DI void load32_pair(const bf16_t* p8, uint2& a, uint2& b, int h2) {
  const u32x4 v = *(const u32x4*)(p8 + h2 * 8);
  a.x = v[0]; a.y = v[1]; b.x = v[2]; b.y = v[3];
  swap32(a.x, b.x); swap32(a.y, b.y);
}
DI int crow(int reg, int h2) { return (reg & 3) + 8 * (reg >> 2) + 4 * h2; }
DI int tid_op() { int t = threadIdx.x; asm volatile("" : "+v"(t)); return t; }
struct Params;
DI unsigned char* ws_op(const Params& p);

constexpr int BK = 64;
DI int lds_byte2(int r, int c) { const int st = (r >> 4) * 2 + (c >> 5), ob = (r & 15) * 64 + (c & 31) * 2; return st * 1024 + (ob ^ (((ob >> 9) & 1) << 5)); }
DI void stage_rc2(int b, int& R, int& C) { const int st = b >> 10, sb = b & 1023, swz = sb ^ (((sb >> 9) & 1) << 5); R = (st >> 1) * 16 + (swz >> 6); C = (st & 1) * 32 + ((swz & 63) >> 1); }
#define WAIT_VM0() asm volatile("s_waitcnt vmcnt(0)" ::: "memory")
template <bool SWAP, int NJ>
DI void gemm_core(const bf16_t* __restrict__ A, int lda, const bf16_t* __restrict__ Bt, int ldb, int K, f32x4 (&acc)[4][NJ], unsigned char* sm, bool pre = false) {
  const int tid = tid_op(), lane = tid & 63, wid = tid >> 6, wm = wid >> 1, wn = wid & 1, fr = lane & 15, fq = lane >> 4;
  int aoff[4], boff[NJ];
#pragma unroll
  for (int i = 0; i < 4; ++i) { int R, C; stage_rc2(wid * 1024 + i * 4096 + lane * 16, R, C); aoff[i] = R * lda + C; }
#pragma unroll
  for (int i = 0; i < NJ; ++i) { int R, C; stage_rc2(wid * 1024 + i * 4096 + lane * 16, R, C); boff[i] = R * ldb + C; }
  const int lo = (fr * 64 + fq * 16) ^ ((fr >> 3) << 5);
  const int nt = K / BK;
  if (!pre) {
    __syncthreads();
#pragma unroll
    for (int i = 0; i < 4; ++i) __builtin_amdgcn_global_load_lds((const unsigned*)(A + aoff[i]), (__attribute__((address_space(3))) unsigned*)(sm + wid * 1024 + i * 4096), 16, 0, 0);
#pragma unroll
    for (int i = 0; i < NJ; ++i) __builtin_amdgcn_global_load_lds((const unsigned*)(Bt + boff[i]), (__attribute__((address_space(3))) unsigned*)(sm + 16384 + wid * 1024 + i * 4096), 16, 0, 0);
  }
  WAIT_VM0();
  __syncthreads();
  for (int t = 0; t < nt; ++t) {
    unsigned char* cur = sm + (t & 1) * 32768;
    unsigned char* nxt = sm + ((t & 1) ^ 1) * 32768;
    if (t + 1 < nt) {
      const int ko = (t + 1) * BK;
#pragma unroll
      for (int i = 0; i < 4; ++i) __builtin_amdgcn_global_load_lds((const unsigned*)(A + aoff[i] + ko), (__attribute__((address_space(3))) unsigned*)(nxt + wid * 1024 + i * 4096), 16, 0, 0);
#pragma unroll
      for (int i = 0; i < NJ; ++i) __builtin_amdgcn_global_load_lds((const unsigned*)(Bt + boff[i] + ko), (__attribute__((address_space(3))) unsigned*)(nxt + 16384 + wid * 1024 + i * 4096), 16, 0, 0);
    }
    bf16x8 af[2][4], bfr[2][NJ];
#pragma unroll
    for (int ks = 0; ks < 2; ++ks) {
#pragma unroll
      for (int i = 0; i < 4; ++i) af[ks][i] = *(const bf16x8*)(cur + ((wm * 4 + i) * 2 + ks) * 1024 + lo);
#pragma unroll
      for (int j = 0; j < NJ; ++j) bfr[ks][j] = *(const bf16x8*)(cur + 16384 + ((wn * NJ + j) * 2 + ks) * 1024 + lo);
      __builtin_amdgcn_sched_barrier(0);
    }
#pragma unroll
    for (int ks = 0; ks < 2; ++ks) {
#pragma unroll
      for (int i = 0; i < 4; ++i)
#pragma unroll
        for (int j = 0; j < NJ; ++j) acc[i][j] = SWAP ? MFMA16(bfr[ks][j], af[ks][i], acc[i][j]) : MFMA16(af[ks][i], bfr[ks][j], acc[i][j]);
      __builtin_amdgcn_sched_barrier(0);
    }
    WAIT_VM0();
    __syncthreads();
  }
}

DI void gemm_issue0(const bf16_t* __restrict__ A, int lda, const bf16_t* __restrict__ Bt, int ldb, unsigned char* sm) {
  const int tid = tid_op(), lane = tid & 63, wid = tid >> 6;
#pragma unroll
  for (int i = 0; i < 4; ++i) {
    int R, C; stage_rc2(wid * 1024 + i * 4096 + lane * 16, R, C);
    __builtin_amdgcn_global_load_lds((const unsigned*)(A + R * lda + C), (__attribute__((address_space(3))) unsigned*)(sm + wid * 1024 + i * 4096), 16, 0, 0);
    __builtin_amdgcn_global_load_lds((const unsigned*)(Bt + R * ldb + C), (__attribute__((address_space(3))) unsigned*)(sm + 16384 + wid * 1024 + i * 4096), 16, 0, 0);
  }
}
template <bool SWAP>
DI void gemm_core256(const bf16_t* __restrict__ A, int lda, const bf16_t* __restrict__ Bt, int ldb, int K, f32x4 (&acc)[8][4], unsigned char* sm) {
  const int tid = tid_op(), lane = tid & 63, wid = tid >> 6, wm = wid >> 1, wn = wid & 1, fr = lane & 15, fq = lane >> 4;
  int aoff[4], boff[2];
#pragma unroll
  for (int i = 0; i < 4; ++i) { const int b = wid * 1024 + i * 4096 + lane * 16, R = b >> 6, c = ((b >> 4) & 3) ^ ((-(R >> 2)) & 3); aoff[i] = R * lda + c * 8; }
#pragma unroll
  for (int i = 0; i < 2; ++i) { const int b = wid * 1024 + i * 4096 + lane * 16, R = b >> 6, c = ((b >> 4) & 3) ^ ((-(R >> 2)) & 3); boff[i] = R * ldb + c * 8; }
  const int lo = fr * 64 + ((fq ^ ((-(fr >> 2)) & 3)) << 4);
  const int nt = K / 32;
  __syncthreads();
#pragma unroll
  for (int i = 0; i < 4; ++i) __builtin_amdgcn_global_load_lds((const unsigned*)(A + aoff[i]), (__attribute__((address_space(3))) unsigned*)(sm + wid * 1024 + i * 4096), 16, 0, 0);
#pragma unroll
  for (int i = 0; i < 2; ++i) __builtin_amdgcn_global_load_lds((const unsigned*)(Bt + boff[i]), (__attribute__((address_space(3))) unsigned*)(sm + 16384 + wid * 1024 + i * 4096), 16, 0, 0);
  WAIT_VM0();
  __syncthreads();
  for (int t = 0; t < nt; ++t) {
    unsigned char* cur = sm + (t & 1) * 24576;
    unsigned char* nxt = sm + ((t & 1) ^ 1) * 24576;
    if (t + 1 < nt) {
      const int ko = (t + 1) * 32;
#pragma unroll
      for (int i = 0; i < 4; ++i) __builtin_amdgcn_global_load_lds((const unsigned*)(A + aoff[i] + ko), (__attribute__((address_space(3))) unsigned*)(nxt + wid * 1024 + i * 4096), 16, 0, 0);
#pragma unroll
      for (int i = 0; i < 2; ++i) __builtin_amdgcn_global_load_lds((const unsigned*)(Bt + boff[i] + ko), (__attribute__((address_space(3))) unsigned*)(nxt + 16384 + wid * 1024 + i * 4096), 16, 0, 0);
    }
    bf16x8 af[8], bfr[4];
#pragma unroll
    for (int i = 0; i < 8; ++i) af[i] = *(const bf16x8*)(cur + (wm * 8 + i) * 1024 + lo);
#pragma unroll
    for (int j = 0; j < 4; ++j) bfr[j] = *(const bf16x8*)(cur + 16384 + (wn * 4 + j) * 1024 + lo);
    __builtin_amdgcn_sched_barrier(0);
#pragma unroll
    for (int i = 0; i < 8; ++i)
#pragma unroll
      for (int j = 0; j < 4; ++j) acc[i][j] = SWAP ? MFMA16(bfr[j], af[i], acc[i][j]) : MFMA16(af[i], bfr[j], acc[i][j]);
    __builtin_amdgcn_sched_barrier(0);
    WAIT_VM0();
    __syncthreads();
  }
}
DI void zero_acc8(f32x4 (&acc)[8][4]) {
#pragma unroll
  for (int i = 0; i < 8; ++i)
#pragma unroll
    for (int j = 0; j < 4; ++j) acc[i][j] = f32x4{0.f, 0.f, 0.f, 0.f};
}
template <int NJ>
DI void zero_acc(f32x4 (&acc)[4][NJ]) {
#pragma unroll
  for (int i = 0; i < 4; ++i)
#pragma unroll
    for (int j = 0; j < NJ; ++j) acc[i][j] = f32x4{0.f, 0.f, 0.f, 0.f};
}

DI void transpose_tile(const float* __restrict__ W, int K, int N, bf16_t* __restrict__ WT, int tile, float* sm) {
  const int tid = tid_op();
  const int ntn = N >> 6, kt = tile / ntn, nt = tile % ntn;
  __syncthreads();
#pragma unroll
  for (int i = 0; i < 4; ++i) {
    int idx = tid + i * 256, row = idx >> 4, c4 = (idx & 15) * 4;
    float4 v = *(const float4*)(W + (size_t)(kt * 64 + row) * N + nt * 64 + c4);
    sm[row * 65 + c4 + 0] = v.x; sm[row * 65 + c4 + 1] = v.y; sm[row * 65 + c4 + 2] = v.z; sm[row * 65 + c4 + 3] = v.w;
  }
  __syncthreads();
  const int n = tid >> 2, kq = (tid & 3) * 16;
  unsigned pk[8];
#pragma unroll
  for (int i = 0; i < 8; ++i) pk[i] = pack2(sm[(kq + 2 * i) * 65 + n], sm[(kq + 2 * i + 1) * 65 + n]);
  uint4* dst = (uint4*)(WT + (size_t)(nt * 64 + n) * K + kt * 64 + kq);
  dst[0] = uint4{pk[0], pk[1], pk[2], pk[3]};
  dst[1] = uint4{pk[4], pk[5], pk[6], pk[7]};
}

DI void ssm_tables(const Params& p, int layer, int g, float* sm, int part, int nparts) {
  float* pwr = sm; float* pwi = pwr + 33 * 64; float* bbr = pwi + 33 * 64; float* bbi = bbr + 1024; float* cr = bbi + 1024; float* ci = cr + 1024;
  const int tid = tid_op(), gi = layer * 32 + g;
  unsigned char* tb = ws_op(p) + OFF_SSMT + (size_t)gi * SSMT_STRIDE;
  __syncthreads();
  if (tid < 64) {
    const float a_re = p.in[8][gi * 64 + tid], a_im = p.in[9][gi * 64 + tid];
    const float dt = expf(p.in[10][gi]);
    const float mag = expf(dt * a_re);
    const float abr = mag * cosf(dt * a_im), abi = mag * sinf(dt * a_im);
    const float den = a_re * a_re + a_im * a_im, nr = abr - 1.0f;
    const float cfr = (nr * a_re + abi * a_im) / den, cfi = (abi * a_re - nr * a_im) / den;
    const float* bre = p.in[11] + ((size_t)gi * 64 + tid) * 16;
    const float* bim = p.in[12] + ((size_t)gi * 64 + tid) * 16;
    for (int m = 0; m < 16; ++m) { const float br = bre[m], bi = bim[m]; bbr[tid * 16 + m] = cfr * br - cfi * bi; bbi[tid * 16 + m] = cfr * bi + cfi * br; }
    float pr = 1.0f, pi = 0.0f;
    for (int t = 0; t <= 32; ++t) { pwr[t * 64 + tid] = pr; pwi[t * 64 + tid] = pi; const float nr2 = pr * abr - pi * abi, ni2 = pr * abi + pi * abr; pr = nr2; pi = ni2; }
    float* a32 = (float*)(tb + SSMT_A32);
    if (part == 0) { a32[tid] = pwr[32 * 64 + tid]; a32[64 + tid] = pwi[32 * 64 + tid]; }
  }
  for (int idx = tid; idx < 1024; idx += 256) { cr[idx] = p.in[13][(size_t)gi * 1024 + idx]; ci[idx] = p.in[14][(size_t)gi * 1024 + idx]; }
  __syncthreads();
  bf16_t* KT = (bf16_t*)(tb + SSMT_KT); bf16_t* P = (bf16_t*)(tb + SSMT_P); bf16_t* Q = (bf16_t*)(tb + SSMT_Q);
  for (int idx = tid + part * 256; idx < 33 * 256; idx += 256 * nparts) {
    const int t1 = idx >> 8, m = (idx >> 4) & 15, mp = idx & 15;
    float acc = 0.f;
    if (t1 > 0) {
      const int t = t1 - 1;
      for (int q = 0; q < 64; ++q) {
        const float ar = pwr[t * 64 + q], ai = pwi[t * 64 + q], br = bbr[q * 16 + mp], bi = bbi[q * 16 + mp];
        acc += cr[m * 64 + q] * (ar * br - ai * bi) - ci[m * 64 + q] * (ar * bi + ai * br);
      }
    }
    KT[idx] = f2bf(acc);
  }
  for (int idx = tid + part * 256; idx < 128 * 512; idx += 256 * nparts) {
    const int pp = idx >> 9, k = idx & 511, j = k >> 4, mp = k & 15, q = pp & 63, e = 31 - j;
    const float ar = pwr[e * 64 + q], ai = pwi[e * 64 + q], br = bbr[q * 16 + mp], bi = bbi[q * 16 + mp];
    P[idx] = f2bf(pp < 64 ? (ar * br - ai * bi) : (ar * bi + ai * br));
  }
  for (int idx = tid + part * 256; idx < 512 * 128; idx += 256 * nparts) {
    const int row = idx >> 7, pp = idx & 127, i = row >> 4, m = row & 15, q = pp & 63;
    const float ar = pwr[(i + 1) * 64 + q], ai = pwi[(i + 1) * 64 + q], c_r = cr[m * 64 + q], c_i = ci[m * 64 + q];
    Q[idx] = f2bf(pp < 64 ? (c_r * ar - c_i * ai) : (-c_r * ai - c_i * ar));
  }
}

struct TrTask { const float* W; bf16_t* WT; int K, N, tile; };
DI TrTask tr_resolve(const Params& p, int u) {
  const int layer = u / 3136, r = u % 3136;
  bf16_t* wl = (bf16_t*)(ws_op(p) + OFF_WT) + (size_t)layer * LAYER_W;
  TrTask t;
  if (r < 2304) { t.W = p.in[2] + (size_t)layer * 1024 * 9216; t.K = 1024; t.N = 9216; t.WT = wl + W_IN_T; t.tile = r; }
  else if (r < 2368) { t.W = p.in[16] + (size_t)layer * 512 * 512; t.K = 512; t.N = 512; t.WT = wl + W_GLU_T; t.tile = r - 2304; }
  else if (r < 2624) { t.W = p.in[18] + (size_t)layer * 1024 * 1024; t.K = 1024; t.N = 1024; t.WT = wl + PA_T; t.tile = r - 2368; }
  else if (r < 2752) { t.W = p.in[19] + (size_t)layer * 512 * 1024; t.K = 512; t.N = 1024; t.WT = wl + PB_T; t.tile = r - 2624; }
  else if (r < 2880) { t.W = p.in[20] + (size_t)layer * 512 * 1024; t.K = 512; t.N = 1024; t.WT = wl + PC_T; t.tile = r - 2752; }
  else { t.W = p.in[21] + (size_t)layer * 1024 * 1024; t.K = 1024; t.N = 1024; t.WT = wl + WO_T; t.tile = r - 2880; }
  return t;
}
DI void tr_load(const TrTask& t, int tid, f32x4 (&v)[4]) {
  const int ntn = t.N >> 6, kt = t.tile / ntn, nt = t.tile % ntn;
#pragma unroll
  for (int i = 0; i < 4; ++i) { const int idx = tid + i * 256, row = idx >> 4, c4 = (idx & 15) * 4; v[i] = __builtin_nontemporal_load((const f32x4*)(t.W + (size_t)(kt * 64 + row) * t.N + nt * 64 + c4)); }
}
DI void tr_finish(const TrTask& t, int tid, const f32x4 (&v)[4], float* sm) {
  const int ntn = t.N >> 6, kt = t.tile / ntn, nt = t.tile % ntn;
  __syncthreads();
#pragma unroll
  for (int i = 0; i < 4; ++i) { const int idx = tid + i * 256, row = idx >> 4, c4 = (idx & 15) * 4; sm[row * 65 + c4 + 0] = v[i][0]; sm[row * 65 + c4 + 1] = v[i][1]; sm[row * 65 + c4 + 2] = v[i][2]; sm[row * 65 + c4 + 3] = v[i][3]; }
  __syncthreads();
  const int n = tid >> 2, kq = (tid & 3) * 16;
  u32x4 lo, hi;
#pragma unroll
  for (int i = 0; i < 4; ++i) { lo[i] = pack2(sm[(kq + 2 * i) * 65 + n], sm[(kq + 2 * i + 1) * 65 + n]); hi[i] = pack2(sm[(kq + 8 + 2 * i) * 65 + n], sm[(kq + 9 + 2 * i) * 65 + n]); }
  u32x4* dst = (u32x4*)(t.WT + (size_t)(nt * 64 + n) * t.K + kt * 64 + kq);
  dst[0] = lo; dst[1] = hi;
}

DI void phase_prologue(const Params& p, unsigned char* smem) {
  float* sm = (float*)smem;
  const int tid = tid_op();
  const int G = (int)gridDim.x, bid = (int)blockIdx.x;
  for (int q = bid; q < 256; q += G) ssm_tables(p, q >> 7, (q >> 2) & 31, sm, q & 3, 4);
  {
    int u = bid;
    f32x4 cur[4], nxt[4];
    if (u < 2 * 3136) { const TrTask t0 = tr_resolve(p, u); tr_load(t0, tid, cur); }
    for (; u < 2 * 3136; u += G) {
      const int un = u + G;
      if (un < 2 * 3136) { const TrTask tn = tr_resolve(p, un); tr_load(tn, tid, nxt); }
      const TrTask t = tr_resolve(p, u);
      tr_finish(t, tid, cur, sm);
#pragma unroll
      for (int i = 0; i < 4; ++i) cur[i] = nxt[i];
    }
  }
  for (int r = bid; r < 512; r += G) {
    const int idx = r * 256 + tid;
    const int pos = idx >> 6, i = idx & 63;
    const float inv = exp2f(-(float)i * (13.287712379549449f / 64.0f));
    const float ang = (float)pos * inv;
    float* cosT = (float*)(ws_op(p) + OFF_ROPE); float* sinT = cosT + 2048 * 64;
    cosT[idx] = cosf(ang); sinT[idx] = sinf(ang);
  }
}

DI void phase_norm(const Params& p, int layer, int half) {
  const float* xin = (layer == 0 ? p.in[0] : p.out) + (size_t)half * TH * DM;
  const float* g = p.in[1] + layer * DM;
  bf16_t* h = (bf16_t*)(ws_op(p) + OFF_H);
  const int tid_ = tid_op(), lane = tid_ & 63, wave = tid_ >> 6;
  const int rstride = (int)gridDim.x * 4;
  for (int row = (int)blockIdx.x * 4 + wave; row < TH; row += rstride * 2) {
    const int row2 = row + rstride; const bool has2 = row2 < TH;
    const float* xa = xin + (size_t)row * DM; const float* xb = xin + (size_t)(has2 ? row2 : row) * DM;
    f32x4 va[4], vb[4]; float sa = 0.f, sb = 0.f;
#pragma unroll
    for (int i = 0; i < 4; ++i) { va[i] = *(const f32x4*)(xa + i * 256 + lane * 4); vb[i] = *(const f32x4*)(xb + i * 256 + lane * 4); }
#pragma unroll
    for (int i = 0; i < 4; ++i) {
      sa += va[i][0] * va[i][0] + va[i][1] * va[i][1] + va[i][2] * va[i][2] + va[i][3] * va[i][3];
      sb += vb[i][0] * vb[i][0] + vb[i][1] * vb[i][1] + vb[i][2] * vb[i][2] + vb[i][3] * vb[i][3];
    }
#pragma unroll
    for (int o = 32; o >= 1; o >>= 1) { sa += shx(sa, o, lane); sb += shx(sb, o, lane); }
    const float ra = rsqrtf(sa * (1.0f / 1024.0f) + EPS), rb = rsqrtf(sb * (1.0f / 1024.0f) + EPS);
#pragma unroll
    for (int i = 0; i < 4; ++i) {
      const f32x4 g4 = *(const f32x4*)(g + i * 256 + lane * 4);
      uint2 o2; o2.x = pack2(va[i][0] * ra * g4[0], va[i][1] * ra * g4[1]); o2.y = pack2(va[i][2] * ra * g4[2], va[i][3] * ra * g4[3]);
      *(uint2*)(h + (size_t)row * DM + i * 256 + lane * 4) = o2;
      if (has2) {
        uint2 o3; o3.x = pack2(vb[i][0] * rb * g4[0], vb[i][1] * rb * g4[1]); o3.y = pack2(vb[i][2] * rb * g4[2], vb[i][3] * rb * g4[3]);
        *(uint2*)(h + (size_t)row2 * DM + i * 256 + lane * 4) = o3;
      }
    }
  }
}

DI void phase_inproj(const Params& p, int layer, unsigned char* smem) {
  const bf16_t* h = (const bf16_t*)(ws_op(p) + OFF_H);
  const bf16_t* WinT = (const bf16_t*)(ws_op(p) + OFF_WT) + (size_t)layer * LAYER_W + W_IN_T;
  bf16_t* proj = (bf16_t*)(ws_op(p) + OFF_PROJ);
  bf16_t* rvt = (bf16_t*)(ws_op(p) + OFF_RVT);
  bf16_t* svt = (bf16_t*)(ws_op(p) + OFF_SVT);
  const int tid_ = tid_op(), lane = tid_ & 63, wave = tid_ >> 6, wm = wave >> 1, wn = wave & 1;
  bool pre = false;
  for (int t = (int)blockIdx.x; t < 128 * 72; t += gridDim.x) {
    const int mt = t / 72, nt = t % 72, m0 = mt * 128, n0 = nt * 128;
    f32x4 acc[4][4]; zero_acc<4>(acc);
    const bool isrv = (n0 >= 1024 && n0 < 2048), issv = (n0 >= 4096 && n0 < 4608);
    const int tn = t + (int)gridDim.x;
    const bool chain = (tn < 128 * 72) && (isrv || issv || n0 >= 1024);
    const bf16_t* An = h + (size_t)((tn / 72) * 128) * DM; const bf16_t* Bn = WinT + (size_t)((tn % 72) * 128) * DM;
    if (isrv || issv) {
      gemm_core<false, 4>(h + (size_t)m0 * DM, DM, WinT + (size_t)n0 * DM, DM, DM, acc, smem, pre);
      pre = chain;
      if (chain) gemm_issue0(An, DM, Bn, DM, smem);
#pragma unroll
      for (int i = 0; i < 4; i += 2)
#pragma unroll
        for (int j = 0; j < 4; ++j) {
          const int mb = m0 + wm * 64 + i * 16, n = n0 + wn * 64 + j * 16 + (lane & 15);
          const int bl = mb >> 11, s = mb & 2047;
          uint2 oa, ob;
          oa.x = pack2(acc[i][j][0], acc[i][j][1]); oa.y = pack2(acc[i][j][2], acc[i][j][3]);
          ob.x = pack2(acc[i + 1][j][0], acc[i + 1][j][1]); ob.y = pack2(acc[i + 1][j][2], acc[i + 1][j][3]);
          bf16_t* rowp;
          if (isrv) { const int c = n - 1024, hh = c >> 8, dv = c & 255; rowp = rvt + ((size_t)((bl * 4 + hh) * 256 + dv)) * 2048 + s; }
          else { const int c = n - 4096, hh = c >> 6, dv = c & 63; rowp = svt + ((size_t)((bl * 8 + hh) * 64 + dv)) * 2048 + s; }
          store16_pair_nt(rowp, oa, ob, lane >> 4);
        }
    } else {
      gemm_core<true, 4>(h + (size_t)m0 * DM, DM, WinT + (size_t)n0 * DM, DM, DM, acc, smem, pre);
      pre = chain;
      if (chain) gemm_issue0(An, DM, Bn, DM, smem);
      const int shift = (n0 >= 2048 ? 1024 : 0) + (n0 >= 4608 ? 512 : 0);
      const int fr = lane & 15, kq = lane >> 4;
      if (n0 >= 3072 && n0 < 4096) {
        const bool isq = n0 < 3584;
        const float* gain = (isq ? p.in[6] : p.in[7]) + layer * 64;
#pragma unroll
        for (int i = 0; i < 4; ++i) {
          float ss = 0.f;
#pragma unroll
          for (int j = 0; j < 4; ++j) ss += acc[i][j][0] * acc[i][j][0] + acc[i][j][1] * acc[i][j][1] + acc[i][j][2] * acc[i][j][2] + acc[i][j][3] * acc[i][j][3];
          ss += shx(ss, 16, lane); ss += shx(ss, 32, lane);
          const float rs = rsqrtf(ss * (1.0f / 64.0f) + EPS) * (isq ? 0.125f : 1.0f);
#pragma unroll
          for (int j = 0; j < 4; ++j) { const float4 g4 = *(const float4*)(gain + j * 16 + kq * 4); acc[i][j][0] *= rs * g4.x; acc[i][j][1] *= rs * g4.y; acc[i][j][2] *= rs * g4.z; acc[i][j][3] *= rs * g4.w; }
        }
      } else if (n0 < 1024) {
        const bool isq = n0 < 512;
        const int hk = (n0 & 511) >> 7;
        const float* gain = (isq ? p.in[3] : p.in[4]) + layer * 128 + wn * 64;
        float* xv = (float*)smem;
        float* ssx = (float*)(smem + 65600);
        const float* cosT = (const float*)(ws_op(p) + OFF_ROPE); const float* sinT = cosT + 2048 * 64;
        float ssp[4];
#pragma unroll
        for (int i = 0; i < 4; ++i) {
          float ss = 0.f;
#pragma unroll
          for (int j = 0; j < 4; ++j) ss += acc[i][j][0] * acc[i][j][0] + acc[i][j][1] * acc[i][j][1] + acc[i][j][2] * acc[i][j][2] + acc[i][j][3] * acc[i][j][3];
          ss += shx(ss, 16, lane); ss += shx(ss, 32, lane);
          ssp[i] = ss;
          if (kq == 0) ssx[wave * 64 + i * 16 + fr] = ss;
        }
        __syncthreads();
#pragma unroll
        for (int i = 0; i < 4; ++i) {
          const float rs = rsqrtf((ssp[i] + ssx[(wave ^ 1) * 64 + i * 16 + fr]) * (1.0f / 128.0f) + EPS);
#pragma unroll
          for (int j = 0; j < 4; ++j) {
            const float4 g4 = *(const float4*)(gain + j * 16 + kq * 4);
            acc[i][j][0] *= rs * g4.x; acc[i][j][1] *= rs * g4.y; acc[i][j][2] *= rs * g4.z; acc[i][j][3] *= rs * g4.w;
#pragma unroll
            for (int r = 0; r < 4; ++r) xv[wave * 4096 + ((i * 4 + j) * 4 + r) * 64 + lane] = acc[i][j][r];
          }
        }
        __syncthreads();
        const float sgn = wn ? 1.0f : -1.0f, ksc = isq ? 1.0f : 0.08838834764831845f;
        const float lg2k = log2f(1.0f - exp2f(-5.0f - (float)hk));
#pragma unroll
        for (int i = 0; i < 4; ++i) {
          const int m = m0 + wm * 64 + i * 16 + fr, pos = m & 2047;
          const float kd = exp2f((float)(127 - (pos & 127)) * lg2k);
          bf16_t* kdst = (bf16_t*)(ws_op(p) + OFF_KDT) + ((size_t)(((m >> 11) * 4 + hk) * 128 + wn * 64)) * 2048 + pos;
#pragma unroll
          for (int j = 0; j < 4; ++j) {
            const float4 c4 = *(const float4*)(cosT + pos * 64 + j * 16 + kq * 4), s4 = *(const float4*)(sinT + pos * 64 + j * 16 + kq * 4);
            const float cc[4] = {c4.x, c4.y, c4.z, c4.w}, sn[4] = {s4.x, s4.y, s4.z, s4.w};
#pragma unroll
            for (int r = 0; r < 4; ++r) {
              const float other = xv[(wave ^ 1) * 4096 + ((i * 4 + j) * 4 + r) * 64 + lane];
              const float o = (acc[i][j][r] * cc[r] + sgn * other * sn[r]) * ksc;
              acc[i][j][r] = o;
              if (!isq) kdst[(size_t)(j * 16 + kq * 4 + r) * 2048] = f2bf(o * kd);
            }
            uint2 o2; o2.x = pack2(acc[i][j][0], acc[i][j][1]); o2.y = pack2(acc[i][j][2], acc[i][j][3]);
            *(uint2*)(proj + (size_t)m * PS + n0 + wn * 64 + j * 16 + kq * 4) = o2;
          }
        }
        continue;
      }
#pragma unroll
      for (int i = 0; i < 4; ++i)
#pragma unroll
        for (int j = 0; j < 4; j += 2) {
          const int m = m0 + wm * 64 + i * 16 + (lane & 15);
          uint2 oa, ob;
          oa.x = pack2(acc[i][j][0], acc[i][j][1]); oa.y = pack2(acc[i][j][2], acc[i][j][3]);
          ob.x = pack2(acc[i][j + 1][0], acc[i][j + 1][1]); ob.y = pack2(acc[i][j + 1][2], acc[i][j + 1][3]);
          store16_pair_nt(proj + (size_t)m * PS + n0 - shift + wn * 64 + j * 16, oa, ob, lane >> 4);
        }
    }
  }
}

DI bf16x8 pack_frag(const f32x16& x, int s) {
  u32x4 p;
  asm volatile("v_cvt_pk_bf16_f32 %0, %4, %5\n\tv_cvt_pk_bf16_f32 %1, %6, %7\n\tv_cvt_pk_bf16_f32 %2, %8, %9\n\tv_cvt_pk_bf16_f32 %3, %10, %11\n\ts_nop 1"
               : "=&v"(p[0]), "=&v"(p[1]), "=&v"(p[2]), "=&v"(p[3])
               : "v"(x[8 * s]), "v"(x[8 * s + 1]), "v"(x[8 * s + 2]), "v"(x[8 * s + 3]), "v"(x[8 * s + 4]), "v"(x[8 * s + 5]), "v"(x[8 * s + 6]), "v"(x[8 * s + 7]));
  return __builtin_bit_cast(bf16x8, p);
}

DI void sb_item(const Params& p, int b, int h, int qi, unsigned char* smem) {
  bf16_t* Ks = (bf16_t*)smem;
  bf16_t* Vt = Ks + 128 * 72;
  const bf16_t* proj = (const bf16_t*)(ws_op(p) + OFF_PROJ);
  const bf16_t* svt = (const bf16_t*)(ws_op(p) + OFF_SVT);
  bf16_t* yb = (bf16_t*)(ws_op(p) + OFF_YB);
  const int tid = tid_op(), lane = tid & 63, wave = tid >> 6, r = lane & 31, h2 = lane >> 5;
  const int qpos = qi * 128 + wave * 32 + r;
  const size_t mq = (size_t)b * 2048 + qpos;
  bf16x8 qf[4];
#pragma unroll
  for (int ks = 0; ks < 4; ++ks) qf[ks] = *(const bf16x8*)(proj + mq * PS + C_SQ + h * 64 + ks * 16 + h2 * 8);
  f32x16 o[2];
#pragma unroll
  for (int i = 0; i < 16; ++i) { o[0][i] = 0.f; o[1][i] = 0.f; }
  float carry = 1.0f;
  u32x4 pk[4], pv[4];
#pragma unroll
  for (int i = 0; i < 4; ++i) {
    const int c = tid + i * 256;
    pk[i] = *(const u32x4*)(proj + ((size_t)b * 2048 + qi * 128 + (c >> 3)) * PS + C_SK + h * 64 + (c & 7) * 8);
    pv[i] = *(const u32x4*)(svt + ((size_t)((b * 8 + h) * 64 + (c >> 4))) * 2048 + qi * 128 + (c & 15) * 8);
  }
  for (int kb = qi; kb >= 0; --kb) {
    __syncthreads();
    if (kb != qi) { const volatile int* vote = (const volatile int*)(smem + 65568); if (vote[0] & vote[1] & vote[2] & vote[3]) break; }
#pragma unroll
    for (int i = 0; i < 4; ++i) {
      const int c = tid + i * 256;
      *(u32x4*)(Ks + (c >> 3) * 72 + (c & 7) * 8) = pk[i];
      *(u32x4*)(Vt + (c >> 4) * 136 + (c & 15) * 8) = pv[i];
    }
    __syncthreads();
    if (kb > 0) {
#pragma unroll
      for (int i = 0; i < 4; ++i) {
        const int c = tid + i * 256;
        pk[i] = *(const u32x4*)(proj + ((size_t)b * 2048 + (kb - 1) * 128 + (c >> 3)) * PS + C_SK + h * 64 + (c & 7) * 8);
        pv[i] = *(const u32x4*)(svt + ((size_t)((b * 8 + h) * 64 + (c >> 4))) * 2048 + (kb - 1) * 128 + (c & 15) * 8);
      }
    }
    const bool diag = (kb == qi);
    for (int kt = 3; kt >= 0; --kt) {
      f32x16 s;
#pragma unroll
      for (int i = 0; i < 16; ++i) s[i] = 0.f;
#pragma unroll
      for (int ks = 0; ks < 4; ++ks) { bf16x8 kf = *(const bf16x8*)(Ks + (kt * 32 + r) * 72 + ks * 16 + h2 * 8); s = MFMA32(kf, qf[ks], s); }
      const int keybase = kb * 128 + kt * 32 + 4 * h2;
      float kp[16];
#pragma unroll
      for (int reg = 0; reg < 16; ++reg) {
        kp[reg] = __builtin_amdgcn_rcpf(1.0f + __expf(s[reg]));
        if (diag) { const int key = keybase + (reg & 3) + 8 * (reg >> 2); kp[reg] = (key < qpos) ? kp[reg] : 1.0f; }
      }
      float G[4], Gp[4], off[4];
#pragma unroll
      for (int g = 0; g < 4; ++g) { G[g] = (kp[4 * g] * kp[4 * g + 1]) * (kp[4 * g + 2] * kp[4 * g + 3]); Gp[g] = shx(G[g], 32, lane); }
      const float T0 = G[0] * Gp[0], T1 = G[1] * Gp[1], T2 = G[2] * Gp[2], T3 = G[3] * Gp[3];
      const float st2 = T3, st1 = T3 * T2, st0 = st1 * T1, total = st0 * T0;
      off[3] = carry; off[2] = carry * st2; off[1] = carry * st1; off[0] = carry * st0;
      if (h2 == 0) { off[0] *= Gp[0]; off[1] *= Gp[1]; off[2] *= Gp[2]; off[3] *= Gp[3]; }
      f32x16 w;
#pragma unroll
      for (int g = 0; g < 4; ++g) {
        float e = off[g];
#pragma unroll
        for (int i = 3; i >= 0; --i) {
          const int reg = 4 * g + i;
          w[reg] = (1.0f - kp[reg]) * e;
          e *= kp[reg];
        }
      }
      carry *= total;
#pragma unroll
      for (int sidx = 0; sidx < 2; ++sidx) {
        const bf16x8 pf = pack_frag(w, sidx);
#pragma unroll
        for (int dt = 0; dt < 2; ++dt) {
          const bf16_t* vp = Vt + (dt * 32 + r) * 136 + kt * 32 + 16 * sidx + 4 * h2;
          const s16x4 lo = *(const s16x4*)vp, hi = *(const s16x4*)(vp + 8);
          const bf16x8 vf = __builtin_shufflevector(lo, hi, 0, 1, 2, 3, 4, 5, 6, 7);
          o[dt] = MFMA32(vf, pf, o[dt]);
        }
      }
    }
    { const int alld = __all(carry < 1e-37f); if (lane == 0) ((volatile int*)(smem + 65568))[wave] = alld ? 1 : 0; }
  }
#pragma unroll
  for (int dt = 0; dt < 2; ++dt)
#pragma unroll
    for (int gp = 0; gp < 4; gp += 2) {
      uint2 zq[2], oq[2];
      load32_pair(proj + mq * PS + C_SZ + h * 64 + dt * 32 + 8 * gp, zq[0], zq[1], h2);
#pragma unroll
      for (int q = 0; q < 2; ++q) {
        const int g = gp + q; const uint2 zz = zq[q];
        const float z0 = bf2f((bf16_t)(zz.x & 0xffff)), z1 = bf2f((bf16_t)(zz.x >> 16)), z2 = bf2f((bf16_t)(zz.y & 0xffff)), z3 = bf2f((bf16_t)(zz.y >> 16));
        oq[q].x = pack2(o[dt][4 * g] * siluf_(z0), o[dt][4 * g + 1] * siluf_(z1)); oq[q].y = pack2(o[dt][4 * g + 2] * siluf_(z2), o[dt][4 * g + 3] * siluf_(z3));
      }
      store32_pair(yb + mq * 512 + h * 64 + dt * 32 + 8 * gp, oq[0], oq[1], h2);
    }
}

DI void ret_item(const Params& p, int b, int h, int es, int part, unsigned char* smem) {
  bf16_t* Ks = (bf16_t*)smem;
  bf16_t* Vt = Ks + 64 * 136;
  bf16_t* St = Vt + 64 * 136;
  const bf16_t* proj = (const bf16_t*)(ws_op(p) + OFF_PROJ);
  const bf16_t* rvt = (const bf16_t*)(ws_op(p) + OFF_RVT);
  const bf16_t* kdt = (const bf16_t*)(ws_op(p) + OFF_KDT);
  bf16_t* ya = (bf16_t*)(ws_op(p) + OFF_YA);
  float* ssq = (float*)(ws_op(p) + OFF_SSQ);
  const int tid = tid_op(), lane = tid & 63, wave = tid >> 6, r = lane & 31, h2 = lane >> 5;
  const float lg2 = log2f(1.0f - exp2f(-5.0f - (float)h));
  const float cdec = exp2f(128.0f * lg2);
  const int il = wave * 32 + r;
  const float qdec = exp2f((float)(il + 1) * lg2);
  f32x16 st[2];
#pragma unroll
  for (int i = 0; i < 16; ++i) { st[0][i] = 0.f; st[1][i] = 0.f; }
  const size_t vrow0 = (size_t)((b * 4 + h) * 256 + es * 64);
  const size_t krow = (size_t)((b * 4 + h) * 128 + wave * 32 + r);
  const int srow = tid >> 4, skc = (tid & 15) * 8;
  if (part) {
    for (int n = 0; n < 8; ++n) {
      bf16x8 kdf[8];
#pragma unroll
      for (int ks = 0; ks < 8; ++ks) kdf[ks] = *(const bf16x8*)(kdt + krow * 2048 + n * 128 + ks * 16 + h2 * 8);
      __syncthreads();
#pragma unroll
      for (int i = 0; i < 4; ++i) { const int row = srow + i * 16; *(u32x4*)(Vt + row * 136 + skc) = *(const u32x4*)(rvt + (vrow0 + row) * 2048 + n * 128 + skc); }
      __syncthreads();
#pragma unroll
      for (int i = 0; i < 16; ++i) { st[0][i] *= cdec; st[1][i] *= cdec; }
#pragma unroll
      for (int ks = 0; ks < 8; ++ks)
#pragma unroll
        for (int et = 0; et < 2; ++et) { const bf16x8 vf = *(const bf16x8*)(Vt + (et * 32 + r) * 136 + ks * 16 + h2 * 8); st[et] = MFMA32(vf, kdf[ks], st[et]); }
    }
  }
  for (int n = part * 8; n < part * 8 + 8; ++n) {
    const size_t mq = (size_t)b * 2048 + n * 128 + il;
    bf16x8 qf[8];
#pragma unroll
    for (int ks = 0; ks < 8; ++ks) qf[ks] = *(const bf16x8*)(proj + mq * PS + C_RQ + h * 128 + ks * 16 + h2 * 8);
    __syncthreads();
#pragma unroll
    for (int et = 0; et < 2; ++et)
#pragma unroll
      for (int reg = 0; reg < 16; ++reg) St[(et * 32 + crow(reg, h2)) * 136 + wave * 32 + r] = f2bf(st[et][reg]);
#pragma unroll
    for (int i = 0; i < 4; ++i) {
      const int row = srow + i * 16;
      *(u32x4*)(Vt + row * 136 + skc) = *(const u32x4*)(rvt + (vrow0 + row) * 2048 + n * 128 + skc);
      *(u32x4*)(Ks + row * 136 + skc) = *(const u32x4*)(proj + ((size_t)b * 2048 + n * 128 + row) * PS + C_RK + h * 128 + skc);
    }
    __syncthreads();
    f32x16 o[2];
#pragma unroll
    for (int i = 0; i < 16; ++i) { o[0][i] = 0.f; o[1][i] = 0.f; }
#pragma unroll
    for (int ks = 0; ks < 8; ++ks)
#pragma unroll
      for (int et = 0; et < 2; ++et) { const bf16x8 sf = *(const bf16x8*)(St + (et * 32 + r) * 136 + ks * 16 + h2 * 8); o[et] = MFMA32(sf, qf[ks], o[et]); }
#pragma unroll
    for (int i = 0; i < 16; ++i) { o[0][i] *= qdec; o[1][i] *= qdec; }
    for (int jh = 0; jh < 2; ++jh) {
      if (jh) {
        __syncthreads();
#pragma unroll
        for (int i = 0; i < 4; ++i) {
          const int row = srow + i * 16;
          *(u32x4*)(Ks + row * 136 + skc) = *(const u32x4*)(proj + ((size_t)b * 2048 + n * 128 + 64 + row) * PS + C_RK + h * 128 + skc);
        }
        __syncthreads();
      }
      for (int kt = 0; kt < 2; ++kt) {
        const int key0 = jh * 64 + kt * 32;
        if (key0 > wave * 32 + 31) continue;
        f32x16 s;
#pragma unroll
        for (int i = 0; i < 16; ++i) s[i] = 0.f;
#pragma unroll
        for (int ks = 0; ks < 8; ++ks) { const bf16x8 kf = *(const bf16x8*)(Ks + (kt * 32 + r) * 136 + ks * 16 + h2 * 8); s = MFMA32(kf, qf[ks], s); }
#pragma unroll
        for (int reg = 0; reg < 16; ++reg) {
          const int dl = il - (key0 + crow(reg, h2));
          s[reg] = (dl >= 0) ? s[reg] * __builtin_amdgcn_exp2f((float)dl * lg2) : 0.f;
        }
#pragma unroll
        for (int sidx = 0; sidx < 2; ++sidx) {
          const bf16x8 pf = pack_frag(s, sidx);
#pragma unroll
          for (int et = 0; et < 2; ++et) {
            const bf16_t* vp = Vt + (et * 32 + r) * 136 + key0 + 16 * sidx + 4 * h2;
            const s16x4 lo = *(const s16x4*)vp, hi = *(const s16x4*)(vp + 8);
            const bf16x8 vf = __builtin_shufflevector(lo, hi, 0, 1, 2, 3, 4, 5, 6, 7);
            o[et] = MFMA32(vf, pf, o[et]);
          }
        }
      }
    }
    bf16x8 kdf[8];
#pragma unroll
    for (int ks = 0; ks < 8; ++ks) kdf[ks] = *(const bf16x8*)(kdt + krow * 2048 + n * 128 + ks * 16 + h2 * 8);
    float ss = 0.f;
#pragma unroll
    for (int i = 0; i < 16; ++i) ss += o[0][i] * o[0][i] + o[1][i] * o[1][i];
    ss += shx(ss, 32, lane);
    if (h2 == 0) ssq[mq * 16 + h * 4 + es] = ss;
#pragma unroll
    for (int et = 0; et < 2; ++et)
#pragma unroll
      for (int g = 0; g < 4; g += 2) {
        uint2 oa, ob;
        oa.x = pack2(o[et][4 * g], o[et][4 * g + 1]); oa.y = pack2(o[et][4 * g + 2], o[et][4 * g + 3]);
        ob.x = pack2(o[et][4 * g + 4], o[et][4 * g + 5]); ob.y = pack2(o[et][4 * g + 6], o[et][4 * g + 7]);
        store32_pair(ya + mq * 1024 + h * 256 + es * 64 + et * 32 + 8 * g, oa, ob, h2);
      }
#pragma unroll
    for (int i = 0; i < 16; ++i) { st[0][i] *= cdec; st[1][i] *= cdec; }
#pragma unroll
    for (int ks = 0; ks < 8; ++ks)
#pragma unroll
      for (int et = 0; et < 2; ++et) { const bf16x8 vf = *(const bf16x8*)(Vt + (et * 32 + r) * 136 + ks * 16 + h2 * 8); st[et] = MFMA32(vf, kdf[ks], st[et]); }
  }
}

DI void ret_finalize(const Params& p, int layer) {
  const bf16_t* proj = (const bf16_t*)(ws_op(p) + OFF_PROJ);
  bf16_t* ya = (bf16_t*)(ws_op(p) + OFF_YA);
  const float* ssq = (const float*)(ws_op(p) + OFF_SSQ);
  const float* gn = p.in[5] + layer * 1024;
  const int tid = tid_op();
  constexpr int U = 4;
  const int stride = (int)gridDim.x * 256;
  for (int base = (int)blockIdx.x * 256 + tid; base < TH * 128; base += stride * U) {
    f32x4 s4[U]; u32x4 ov[U], zv[U];
#pragma unroll
    for (int u = 0; u < U; ++u) {
      const int idx = base + u * stride;
      if (idx < TH * 128) {
        const size_t tok = idx >> 7; const int c8 = (idx & 127) * 8, head = c8 >> 8;
        s4[u] = *(const f32x4*)(ssq + tok * 16 + head * 4);
        ov[u] = *(const u32x4*)(ya + tok * 1024 + c8);
        zv[u] = *(const u32x4*)(proj + tok * PS + C_RZ + c8);
      }
    }
#pragma unroll
    for (int u = 0; u < U; ++u) {
      const int idx = base + u * stride;
      if (idx < TH * 128) {
        const size_t tok = idx >> 7; const int c8 = (idx & 127) * 8;
        const float rstd = rsqrtf((s4[u][0] + s4[u][1] + s4[u][2] + s4[u][3]) * (1.0f / 256.0f) + EPS);
        const f32x4 g0 = *(const f32x4*)(gn + c8), g1 = *(const f32x4*)(gn + c8 + 4);
        u32x4 res;
#pragma unroll
        for (int q = 0; q < 4; ++q) {
          const float o0 = bf2f((bf16_t)(ov[u][q] & 0xffff)), o1 = bf2f((bf16_t)(ov[u][q] >> 16));
          const float z0 = bf2f((bf16_t)(zv[u][q] & 0xffff)), z1 = bf2f((bf16_t)(zv[u][q] >> 16));
          const float ga = (q < 2) ? g0[2 * q] : g1[2 * q - 4], gb = (q < 2) ? g0[2 * q + 1] : g1[2 * q - 3];
          res[q] = pack2(o0 * rstd * ga * siluf_(z0), o1 * rstd * gb * siluf_(z1));
        }
        *(u32x4*)(ya + tok * 1024 + c8) = res;
      }
    }
  }
}

DI void ssm_item(const Params& p, int layer, int b, int g, unsigned char* smem) {
  float* Ss = (float*)smem;
  bf16_t* KTs = (bf16_t*)smem;
  bf16_t* Hp = (bf16_t*)(smem + 33792);
  const bf16_t* proj = (const bf16_t*)(ws_op(p) + OFF_PROJ);
  bf16_t* ycp = (bf16_t*)(ws_op(p) + OFF_YCP);
  const int gi = layer * 32 + g;
  const unsigned char* tb = ws_op(p) + OFF_SSMT + (size_t)gi * SSMT_STRIDE;
  const bf16_t* KTg = (const bf16_t*)(tb + SSMT_KT); const bf16_t* Pg = (const bf16_t*)(tb + SSMT_P); const bf16_t* Qg = (const bf16_t*)(tb + SSMT_Q);
  const float* a32 = (const float*)(tb + SSMT_A32);
  const int tid = tid_op(), lane = tid & 63, wave = tid >> 6, fr = lane & 15, kq = lane >> 4;
  const int chunk = wave * 16 + fr;
  const bf16_t* ubase = proj + ((size_t)b * 2048 + chunk * 32 + (kq >> 1)) * PS + C_CU + g * 16 + 8 * (kq & 1);
  bf16x8 ub[16];
#pragma unroll
  for (int jp = 0; jp < 16; ++jp) ub[jp] = *(const bf16x8*)(ubase + (size_t)(2 * jp) * PS);
  __syncthreads();
#pragma unroll 1
  for (int mt = 0; mt < 8; ++mt) {
    f32x4 acc = {0.f, 0.f, 0.f, 0.f};
    const bf16_t* prow = Pg + (size_t)(mt * 16 + fr) * 512 + kq * 8;
#pragma unroll
    for (int ks = 0; ks < 16; ++ks) { const bf16x8 pf = *(const bf16x8*)(prow + ks * 32); acc = MFMA16(pf, ub[ks], acc); }
    *(f32x4*)(Ss + chunk * 132 + mt * 16 + kq * 4) = acc;
  }
  __syncthreads();
  if (wave == 0) {
    const float ar = a32[lane], ai = a32[64 + lane];
    float hr = 0.f, hi = 0.f;
    for (int c = 0; c < 64; ++c) {
      Hp[c * 136 + lane] = f2bf(hr); Hp[c * 136 + 64 + lane] = f2bf(hi);
      const float sr = Ss[c * 132 + lane], si = Ss[c * 132 + 64 + lane];
      const float nr = ar * hr - ai * hi + sr, ni = ar * hi + ai * hr + si;
      hr = nr; hi = ni;
    }
  }
  __syncthreads();
  for (int c = tid; c < 1056; c += 256) *(u32x4*)(KTs + c * 8) = *(const u32x4*)(KTg + c * 8);
  __syncthreads();
  float dsk[4];
#pragma unroll
  for (int i = 0; i < 4; ++i) dsk[i] = p.in[15][layer * 512 + g * 16 + kq * 4 + i];
  const int th = kq >> 1;
  const bf16_t* ktl = KTs + fr * 16 + 8 * (kq & 1);
#pragma unroll 1
  for (int ih = 0; ih < 2; ++ih) {
    f32x4 acc[16];
#pragma unroll
    for (int ii = 0; ii < 16; ++ii) {
      acc[ii] = f32x4{0.f, 0.f, 0.f, 0.f};
      const bf16_t* qrow = Qg + (size_t)((ih * 16 + ii) * 16 + fr) * 128 + kq * 8;
#pragma unroll
      for (int ks = 0; ks < 4; ++ks) { const bf16x8 qf = *(const bf16x8*)(qrow + ks * 32); const bf16x8 hbk = *(const bf16x8*)(Hp + chunk * 136 + ks * 32 + kq * 8); acc[ii] = MFMA16(qf, hbk, acc[ii]); }
    }
    if (ih == 0) {
#pragma unroll
      for (int ii = 0; ii < 16; ++ii)
#pragma unroll
        for (int jp = 0; jp <= (ii >> 1); ++jp) {
          const int t1 = ii - 2 * jp - th + 1;
          const bf16x8 kf = *(const bf16x8*)(ktl + t1 * 256);
          acc[ii] = MFMA16(kf, ub[jp], acc[ii]);
        }
    } else {
#pragma unroll
      for (int ii = 0; ii < 16; ++ii)
#pragma unroll
        for (int jp = 0; jp <= ((16 + ii) >> 1); ++jp) {
          const int t1 = 16 + ii - 2 * jp - th + 1;
          const bf16x8 kf = *(const bf16x8*)(ktl + t1 * 256);
          acc[ii] = MFMA16(kf, ub[jp], acc[ii]);
        }
    }
#pragma unroll
    for (int ii = 0; ii < 16; ii += 2) {
      const size_t tok = (size_t)b * 2048 + chunk * 32 + ih * 16 + ii;
      uint2 uq[2], oq[2];
      load16_pair(proj + tok * PS + C_CU + g * 16, uq[0], uq[1], kq, PS);
#pragma unroll
      for (int q = 0; q < 2; ++q) {
        const uint2 uu = uq[q];
        const float y0 = gelu_tanh(acc[ii + q][0] + dsk[0] * bf2f((bf16_t)(uu.x & 0xffff)));
        const float y1 = gelu_tanh(acc[ii + q][1] + dsk[1] * bf2f((bf16_t)(uu.x >> 16)));
        const float y2 = gelu_tanh(acc[ii + q][2] + dsk[2] * bf2f((bf16_t)(uu.y & 0xffff)));
        const float y3 = gelu_tanh(acc[ii + q][3] + dsk[3] * bf2f((bf16_t)(uu.y >> 16)));
        oq[q].x = pack2(y0, y1); oq[q].y = pack2(y2, y3);
      }
      store16_pair(ycp + tok * 512 + g * 16, oq[0], oq[1], kq, 512);
    }
  }
}

DI void phase_mixers(const Params& p, int layer, int half, unsigned char* smem) {
  const int NI = 256 + 256 + 1024;
  int* ctr = (int*)(ws_op(p) + OFF_CTR) + (layer * 2 + half);
  int* s_item = (int*)(smem + 65536);
  const int tid = tid_op();
  for (;;) {
    __syncthreads();
    if (tid == 0) *s_item = atomicAdd(ctr, 1);
    __syncthreads();
    const int id = *s_item;
    if (id >= NI) break;
    if (id < 256) ssm_item(p, layer, id >> 5, id & 31, smem);
    else if (id < 512) { const int j = id - 256, q = j & 127; ret_item(p, q >> 4, (q >> 2) & 3, q & 3, 1 - (j >> 7), smem); }
    else { const int j = id - 512, r = j & 63; sb_item(p, r >> 3, r & 7, 15 - (j >> 6), smem); }
  }
}

DI void phase_glu(const Params& p, int layer, unsigned char* smem) {
  const bf16_t* ycp = (const bf16_t*)(ws_op(p) + OFF_YCP);
  const bf16_t* WT = (const bf16_t*)(ws_op(p) + OFF_WT) + (size_t)layer * LAYER_W + W_GLU_T;
  const bf16_t* proj = (const bf16_t*)(ws_op(p) + OFF_PROJ);
  bf16_t* yc = (bf16_t*)(ws_op(p) + OFF_YC);
  const float* bg = p.in[17] + layer * 512;
  const int tid_ = tid_op(), lane = tid_ & 63, wave = tid_ >> 6, wm = wave >> 1, wn = wave & 1;
  for (int t = (int)blockIdx.x; t < 128 * 4; t += gridDim.x) {
    const int m0 = (t >> 2) * 128, n0 = (t & 3) * 128;
    f32x4 acc[4][4]; zero_acc<4>(acc);
    gemm_core<true, 4>(ycp + (size_t)m0 * 512, 512, WT + (size_t)n0 * 512, 512, 512, acc, smem);
    u32x4 yraw[8], zraw[8];
#pragma unroll
    for (int i = 0; i < 4; ++i)
#pragma unroll
      for (int jp = 0; jp < 4; jp += 2) {
        const size_t m = m0 + wm * 64 + i * 16 + (lane & 15); const int nb = n0 + wn * 64 + jp * 16;
        yraw[i * 2 + (jp >> 1)] = *pair_ptr(ycp + m * 512 + nb, lane >> 4);
        zraw[i * 2 + (jp >> 1)] = *pair_ptr(proj + m * PS + C_CZ + nb, lane >> 4);
      }
#pragma unroll
    for (int i = 0; i < 4; ++i)
#pragma unroll
      for (int jp = 0; jp < 4; jp += 2) {
        const size_t m = m0 + wm * 64 + i * 16 + (lane & 15); const int nb = n0 + wn * 64 + jp * 16;
        uint2 yq[2], zq[2], oq[2];
        unpack16_pair(yraw[i * 2 + (jp >> 1)], yq[0], yq[1]);
        unpack16_pair(zraw[i * 2 + (jp >> 1)], zq[0], zq[1]);
#pragma unroll
        for (int q = 0; q < 2; ++q) {
          const int j = jp + q; const uint2 yy = yq[q], zz = zq[q];
          const float4 b4 = *(const float4*)(bg + nb + q * 16 + (lane >> 4) * 4);
          const float y0 = bf2f((bf16_t)(yy.x & 0xffff)), y1 = bf2f((bf16_t)(yy.x >> 16)), y2 = bf2f((bf16_t)(yy.y & 0xffff)), y3 = bf2f((bf16_t)(yy.y >> 16));
          const float z0 = bf2f((bf16_t)(zz.x & 0xffff)), z1 = bf2f((bf16_t)(zz.x >> 16)), z2 = bf2f((bf16_t)(zz.y & 0xffff)), z3 = bf2f((bf16_t)(zz.y >> 16));
          oq[q].x = pack2(y0 * sigmoidf_(acc[i][j][0] + b4.x) * siluf_(z0), y1 * sigmoidf_(acc[i][j][1] + b4.y) * siluf_(z1));
          oq[q].y = pack2(y2 * sigmoidf_(acc[i][j][2] + b4.z) * siluf_(z2), y3 * sigmoidf_(acc[i][j][3] + b4.w) * siluf_(z3));
        }
        store16_pair(yc + m * 512 + nb, oq[0], oq[1], lane >> 4);
      }
  }
}

DI void phase_merge(const Params& p, int layer, unsigned char* smem) {
  const bf16_t* wl = (const bf16_t*)(ws_op(p) + OFF_WT) + (size_t)layer * LAYER_W;
  const bf16_t* ya = (const bf16_t*)(ws_op(p) + OFF_YA);
  const bf16_t* yb = (const bf16_t*)(ws_op(p) + OFF_YB);
  const bf16_t* yc = (const bf16_t*)(ws_op(p) + OFF_YC);
  const bf16_t* proj = (const bf16_t*)(ws_op(p) + OFF_PROJ);
  bf16_t* merged = (bf16_t*)(ws_op(p) + OFF_H);
  const int tid_ = tid_op(), lane = tid_ & 63, wave = tid_ >> 6, wm = wave >> 1, wn = wave & 1;
  for (int t = (int)blockIdx.x; t < 128 * 8; t += gridDim.x) {
    const int m0 = (t >> 3) * 128, n0 = (t & 7) * 128;
    f32x4 mg[4][4]; zero_acc<4>(mg);
#pragma unroll 1
    for (int br = 0; br < 3; ++br) {
      f32x4 acc[4][4]; zero_acc<4>(acc);
      if (br == 0) gemm_core<true, 4>(ya + (size_t)m0 * 1024, 1024, wl + PA_T + (size_t)n0 * 1024, 1024, 1024, acc, smem);
      else if (br == 1) gemm_core<true, 4>(yb + (size_t)m0 * 512, 512, wl + PB_T + (size_t)n0 * 512, 512, 512, acc, smem);
      else gemm_core<true, 4>(yc + (size_t)m0 * 512, 512, wl + PC_T + (size_t)n0 * 512, 512, 512, acc, smem);
      const int gcol = (br == 0) ? C_GA : (br == 1 ? C_GB : C_GC);
      u32x4 graw[8];
#pragma unroll
      for (int i = 0; i < 4; ++i)
#pragma unroll
        for (int jp = 0; jp < 4; jp += 2) graw[i * 2 + (jp >> 1)] = *pair_ptr(proj + (size_t)(m0 + wm * 64 + i * 16 + (lane & 15)) * PS + gcol + n0 + wn * 64 + jp * 16, lane >> 4);
#pragma unroll
      for (int i = 0; i < 4; ++i)
#pragma unroll
        for (int jp = 0; jp < 4; jp += 2) {
          uint2 gq[2];
          unpack16_pair(graw[i * 2 + (jp >> 1)], gq[0], gq[1]);
#pragma unroll
          for (int q = 0; q < 2; ++q) {
            const int j = jp + q; const uint2 gg = gq[q];
            mg[i][j][0] += sigmoidf_(bf2f((bf16_t)(gg.x & 0xffff))) * acc[i][j][0];
            mg[i][j][1] += sigmoidf_(bf2f((bf16_t)(gg.x >> 16))) * acc[i][j][1];
            mg[i][j][2] += sigmoidf_(bf2f((bf16_t)(gg.y & 0xffff))) * acc[i][j][2];
            mg[i][j][3] += sigmoidf_(bf2f((bf16_t)(gg.y >> 16))) * acc[i][j][3];
          }
        }
    }
#pragma unroll
    for (int i = 0; i < 4; ++i)
#pragma unroll
      for (int j = 0; j < 4; j += 2) {
        const size_t m = m0 + wm * 64 + i * 16 + (lane & 15);
        uint2 oa, ob;
        oa.x = pack2(mg[i][j][0], mg[i][j][1]); oa.y = pack2(mg[i][j][2], mg[i][j][3]);
        ob.x = pack2(mg[i][j + 1][0], mg[i][j + 1][1]); ob.y = pack2(mg[i][j + 1][2], mg[i][j + 1][3]);
        store16_pair(merged + m * 1024 + n0 + wn * 64 + j * 16, oa, ob, lane >> 4);
      }
  }
}

DI void phase_out(const Params& p, int layer, int half, unsigned char* smem) {
  const bf16_t* wl = (const bf16_t*)(ws_op(p) + OFF_WT) + (size_t)layer * LAYER_W;
  const bf16_t* merged = (const bf16_t*)(ws_op(p) + OFF_H);
  const float* xin = (layer == 0 ? p.in[0] : p.out) + (size_t)half * TH * DM;
  float* xout = p.out + (size_t)half * TH * DM;
  const int tid_ = tid_op(), lane = tid_ & 63, wave = tid_ >> 6, wm = wave >> 1, wn = wave & 1;
  for (int t = (int)blockIdx.x; t < 64 * 8; t += gridDim.x) {
    const int m0 = (t >> 3) * 256, n0 = (t & 7) * 128;
    f32x4 acc[8][4]; zero_acc8(acc);
    gemm_core256<true>(merged + (size_t)m0 * 1024, 1024, wl + WO_T + (size_t)n0 * 1024, 1024, 1024, acc, smem);
#pragma unroll
    for (int i = 0; i < 8; ++i)
#pragma unroll
      for (int j = 0; j < 4; ++j) {
        const size_t m = m0 + wm * 128 + i * 16 + (lane & 15); const int n = n0 + wn * 64 + j * 16 + (lane >> 4) * 4;
        const f32x4 xv = __builtin_nontemporal_load((const f32x4*)(xin + m * DM + n));
        const f32x4 ov = xv + acc[i][j];
        if (layer == 1) __builtin_nontemporal_store(ov, (f32x4*)(xout + m * DM + n));
        else *(f32x4*)(xout + m * DM + n) = ov;
      }
  }
}

#define XB_TMO      128
#define XB_XCNT(j)  (256  + 64 * (j))
#define XB_XSUB(j)  (1280 + 64 * (j))
#define XB_XGEN(j)  (2304 + 64 * (j))
#define XB_TOP      3328
#define XB_TOPGEN   3392
#define XCD_BAR_WORDS 3456
#define XB_SPIN_CAP (1u << 18)
DI unsigned xb_ld(unsigned* p) { return __hip_atomic_load(p, __ATOMIC_RELAXED, __HIP_MEMORY_SCOPE_AGENT); }
DI unsigned xb_add(unsigned* p, unsigned v) { return __hip_atomic_fetch_add(p, v, __ATOMIC_RELAXED, __HIP_MEMORY_SCOPE_AGENT); }
DI unsigned xb_xcc_id() { return (unsigned)__builtin_amdgcn_s_getreg((3 << 11) | 20) & 0xFu; }
#define XB_SPIN(cond, bar) do { unsigned _sp = 0; while (cond) { __builtin_amdgcn_s_sleep(1); \
    if ((++_sp & 255u) == 0u) { if (xb_ld(&(bar)[XB_TMO])) break; if (_sp > XB_SPIN_CAP) { atomicAdd(&(bar)[XB_TMO], 1u); break; } } } } while (0)
struct XcdBarrier { unsigned* bar; unsigned x; volatile unsigned* st; };
DI XcdBarrier xcd_barrier_post(unsigned* bar, volatile unsigned* st) {
  XcdBarrier b; b.bar = bar; b.x = xb_xcc_id(); b.st = st;
  if (threadIdx.x == 0) (void)xb_add(&bar[XB_XCNT(b.x)], 1u);
  return b;
}
DI void xcd_barrier_complete(unsigned* bar, unsigned x, unsigned& nloc, unsigned& nx) {
  const unsigned G = gridDim.x;
  unsigned sum, cnt, mine, sp = 0u;
  for (;;) {
    sum = 0u; cnt = 0u; mine = 0u;
#pragma unroll
    for (unsigned j = 0; j < 16; ++j) { const unsigned c = xb_ld(&bar[XB_XCNT(j)]); sum += c; cnt += (c > 0u) ? 1u : 0u; mine = (j == x) ? c : mine; }
    if (sum == G) break;
    __builtin_amdgcn_s_sleep(1);
    if ((++sp & 255u) == 0u) { if (xb_ld(&bar[XB_TMO])) break; if (sp > XB_SPIN_CAP) { atomicAdd(&bar[XB_TMO], 1u); break; } }
  }
  nloc = mine > 0u ? mine : 1u; nx = cnt > 0u ? cnt : 1u;
}
DI void xcd_barrier(const XcdBarrier& b_unused, const Params& p, unsigned char* smem) {
  XcdBarrier b; b.x = xb_xcc_id(); b.st = (volatile unsigned*)(smem + 65552); b.bar = nullptr;
  asm volatile("s_waitcnt vmcnt(0)" ::: "memory");
  __syncthreads();
  if (threadIdx.x == 0) {
    unsigned* bar = (unsigned*)(ws_op(p) + OFF_BAR);
    __builtin_amdgcn_s_waitcnt(0);
    unsigned nloc = b.st[0], nx = b.st[1];
    if (nloc == 0u) { xcd_barrier_complete(bar, b.x, nloc, nx); b.st[0] = nloc; b.st[1] = nx; }
    const unsigned old = xb_add(&bar[XB_XSUB(b.x)], 1u);
    const unsigned gen = old / nloc;
    if (old + 1u == (gen + 1u) * nloc) {
      __builtin_amdgcn_fence(__ATOMIC_RELEASE, "agent");
      asm volatile("s_waitcnt vmcnt(0)" ::: "memory");
      const unsigned og = xb_add(&bar[XB_TOP], 1u);
      const unsigned tg = og / nx;
      if (og + 1u == (tg + 1u) * nx) xb_add(&bar[XB_TOPGEN], 1u);
      else XB_SPIN(xb_ld(&bar[XB_TOPGEN]) == tg, bar);
      __builtin_amdgcn_fence(__ATOMIC_ACQUIRE, "agent");
      xb_add(&bar[XB_XGEN(b.x)], 1u);
      asm volatile("s_waitcnt vmcnt(0)" ::: "memory");
    } else {
      XB_SPIN(xb_ld(&bar[XB_XGEN(b.x)]) == gen, bar);
      __builtin_amdgcn_fence(__ATOMIC_ACQUIRE, "agent");
      asm volatile("s_waitcnt vmcnt(0)" ::: "memory");
    }
  }
  __syncthreads();
}

__global__ void __launch_bounds__(256, 2) fwd_megakernel(Params p) {
  cg::grid_group grid = cg::this_grid();
  extern __shared__ __attribute__((aligned(1024))) unsigned char smem[];
  volatile unsigned* xst = (volatile unsigned*)(smem + 65552);
  if (threadIdx.x == 0) { xst[0] = 0u; xst[1] = 0u; }
  __syncthreads();
  const XcdBarrier xb = xcd_barrier_post((unsigned*)(ws_op(p) + OFF_BAR), xst);
  phase_prologue(p, smem);
  phase_norm(p, 0, 0);
  if (p.use_cg_sync) grid.sync();
  xcd_barrier(xb, p, smem);
  for (int layer = 0; layer < 2; ++layer)
    for (int half = 0; half < 2; ++half) {
      if (layer | half) { phase_norm(p, layer, half); xcd_barrier(xb, p, smem); }
      phase_inproj(p, layer, smem);
      xcd_barrier(xb, p, smem);
      phase_mixers(p, layer, half, smem);
      xcd_barrier(xb, p, smem);
      phase_glu(p, layer, smem);
      ret_finalize(p, layer);
      xcd_barrier(xb, p, smem);
      phase_merge(p, layer, smem);
      xcd_barrier(xb, p, smem);
      phase_out(p, layer, half, smem);
      xcd_barrier(xb, p, smem);
    }
}

extern "C" void kernel_launch(void* const* d_in, const int* in_sizes, int n_in, void* d_out, int out_size, void* d_ws, size_t ws_size, hipStream_t stream) {
  static int grid_blocks = 0;
  if (grid_blocks == 0) {
    if (n_in != 22 || ws_size < WS_END) { fprintf(stderr, "kernel_launch: unexpected n_in %d or ws_size %zu (need %zu)\n", n_in, ws_size, (size_t)WS_END); grid_blocks = -1; return; }
    int dev = 0, cus = 0, per_cu = 0;
    hipGetDevice(&dev);
    hipDeviceGetAttribute(&cus, hipDeviceAttributeMultiprocessorCount, dev);
    if (hipFuncSetAttribute((const void*)fwd_megakernel, hipFuncAttributeMaxDynamicSharedMemorySize, SMEM_BYTES) != hipSuccess) { fprintf(stderr, "kernel_launch: hipFuncSetAttribute failed\n"); grid_blocks = -1; return; }
    hipOccupancyMaxActiveBlocksPerMultiprocessor(&per_cu, fwd_megakernel, 256, SMEM_BYTES);
    if (per_cu > 2) per_cu = 2;
    if (per_cu < 1) per_cu = 1;
    grid_blocks = cus * per_cu;
  }
  if (grid_blocks < 0) return;
  Params p{};
  for (int i = 0; i < 22; ++i) p.in[i] = (const float*)d_in[i];
  p.out = (float*)d_out; p.ws = (unsigned char*)d_ws; p.use_cg_sync = 0; p.pad_ = 0;
  if (hipMemsetAsync((unsigned char*)d_ws + OFF_CTR, 0, 256 + 3456 * 4, stream) != hipSuccess) { fprintf(stderr, "kernel_launch: memset of control words failed\n"); return; }
  void* args[] = {&p};
  hipError_t e = hipLaunchCooperativeKernel((void*)fwd_megakernel, dim3(grid_blocks), dim3(256), args, SMEM_BYTES, stream);
  if (e != hipSuccess) fprintf(stderr, "cooperative launch failed: %s (grid %d)\n", hipGetErrorString(e), grid_blocks);
}
```
